# Optimizing an MI355X kernel written in HIP

```python
import math
import jax, jax.numpy as jnp
from jax import lax
import numpy as np

D_MODEL = 2048
BATCH = 2
SEQ = 4096
DEPTH = 1

N_META = 16
BLOCK = 128
N_PAD = BLOCK - N_META
WINDOW = 128
ATT_HEADS = 16
ATT_KV_HEADS = 4
ATT_GROUP = ATT_HEADS // ATT_KV_HEADS
ATT_HEAD_DIM = D_MODEL // 32
ATT_WIDTH = ATT_HEADS * ATT_HEAD_DIM
ATT_KV_WIDTH = ATT_KV_HEADS * ATT_HEAD_DIM
ML_HEADS = 4
ML_V_DIM = D_MODEL // 8
ML_QK_DIM = ML_V_DIM // 2
ML_WIDTH = ML_HEADS * ML_V_DIM
ML_QK_WIDTH = ML_HEADS * ML_QK_DIM
CONV_WIDTH = 4
GATE_SOFTCAP = 15.0
IN_SIZES = (ATT_WIDTH, ATT_KV_WIDTH, ATT_KV_WIDTH,
            ML_QK_WIDTH, ML_QK_WIDTH, ML_WIDTH,
            ML_WIDTH, ML_HEADS, ML_HEADS)
IN_COLS = sum(IN_SIZES)
MIX_WIDTH = ATT_WIDTH + ML_WIDTH
D_FF = 4 * D_MODEL
N_BUCKETS = 32
MAX_DISTANCE = 128
EPS = 1e-6
NEG = -1e30

kernel_name = "hymba_swa_sink_mlstm_sqrelu"


def rmsnorm(x, g):
    x32 = x.astype(jnp.float32)
    y = x32 * lax.rsqrt(jnp.mean(x32 * x32, axis=-1, keepdims=True) + EPS)
    return (y * g.astype(jnp.float32)).astype(x.dtype)


def t5_bucket(dist):
    max_exact = N_BUCKETS // 2
    d = jnp.maximum(dist, 0)
    ratio = jnp.maximum(d, max_exact).astype(jnp.float32) / max_exact
    large = max_exact + (jnp.log(ratio) / math.log(MAX_DISTANCE / max_exact)
                         * (N_BUCKETS - max_exact)).astype(jnp.int32)
    large = jnp.minimum(large, N_BUCKETS - 1)
    return jnp.where(d < max_exact, d, large)


def positional_tables(rel_bias, n_blocks):
    seq_len = n_blocks * BLOCK
    r = jnp.arange(BLOCK)[:, None]
    c = jnp.arange(2 * BLOCK)[None, :]
    dist_band = r + BLOCK - c
    bias_band = rel_bias.astype(jnp.float32)[t5_bucket(dist_band)]
    bias_band = bias_band.reshape(BLOCK, 2 * BLOCK, ATT_KV_HEADS, ATT_GROUP).transpose(2, 3, 0, 1)
    blk = jnp.arange(n_blocks)[:, None, None]
    k_pos = (blk - 1) * BLOCK + c[None]
    mask_band = (dist_band >= 0) & (dist_band < WINDOW) & (k_pos >= BLOCK)
    q_pos = jnp.arange(seq_len)[:, None]
    m_pos = N_PAD + jnp.arange(N_META)[None, :]
    dist_meta = q_pos - m_pos
    bias_meta = rel_bias.astype(jnp.float32)[t5_bucket(dist_meta)]
    bias_meta = bias_meta.reshape(n_blocks, BLOCK, N_META, ATT_KV_HEADS, ATT_GROUP).transpose(0, 3, 4, 1, 2)
    mask_meta = (dist_meta >= 0).reshape(n_blocks, BLOCK, N_META)
    return bias_band, mask_band, bias_meta, mask_meta


def swa_sink_attention(q, k, v, sinks, bias_band, mask_band, bias_meta, mask_meta):
    B, LP, _ = q.shape
    NB = LP // BLOCK
    q = q.reshape(B, NB, BLOCK, ATT_KV_HEADS, ATT_GROUP, ATT_HEAD_DIM)
    k = k.reshape(B, NB, BLOCK, ATT_KV_HEADS, ATT_HEAD_DIM)
    v = v.reshape(B, NB, BLOCK, ATT_KV_HEADS, ATT_HEAD_DIM)
    k_prev = jnp.concatenate([jnp.zeros_like(k[:, :1]), k[:, :-1]], axis=1)
    v_prev = jnp.concatenate([jnp.zeros_like(v[:, :1]), v[:, :-1]], axis=1)
    k_band = jnp.concatenate([k_prev, k], axis=2)
    v_band = jnp.concatenate([v_prev, v], axis=2)
    k_meta = k[:, 0, N_PAD:]
    v_meta = v[:, 0, N_PAD:]
    scale = ATT_HEAD_DIM ** -0.5
    s_band = jnp.einsum('bnqhgd,bnkhd->bnhgqk', q, k_band).astype(jnp.float32) * scale + bias_band
    s_meta = jnp.einsum('bnqhgd,bmhd->bnhgqm', q, k_meta).astype(jnp.float32) * scale + bias_meta
    logits = jnp.concatenate([s_band, s_meta], axis=-1)
    mask = jnp.concatenate([mask_band, mask_meta], axis=-1)[:, None, None]
    logits = jnp.where(mask, logits, NEG)
    sink = sinks.astype(jnp.float32).reshape(ATT_KV_HEADS, ATT_GROUP)[:, :, None, None]
    m = jnp.maximum(jnp.max(logits, axis=-1, keepdims=True), sink)
    p = jnp.exp(logits - m)
    denom = jnp.sum(p, axis=-1, keepdims=True) + jnp.exp(sink - m)
    p = (p / denom).astype(v.dtype)
    o = (jnp.einsum('bnhgqk,bnkhd->bnqhgd', p[..., :2 * BLOCK], v_band)
         + jnp.einsum('bnhgqm,bmhd->bnqhgd', p[..., 2 * BLOCK:], v_meta))
    return o.reshape(B, LP, ATT_WIDTH)


def causal_conv_silu(x, w, b):
    L = x.shape[1]
    xp = jnp.pad(x, ((0, 0), (CONV_WIDTH - 1, 0), (0, 0)))
    y = b
    for j in range(CONV_WIDTH):
        y = y + xp[:, j:j + L] * w[j]
    return jax.nn.silu(y)


def mlstm_chunkwise(q, k, v, i_pre, f_pre, valid):
    B, LP, _ = q.shape
    NC = LP // BLOCK
    f32 = jnp.float32
    q = q.astype(f32).reshape(B, NC, BLOCK, ML_HEADS, ML_QK_DIM) * (ML_QK_DIM ** -0.5)
    k = k.astype(f32).reshape(B, NC, BLOCK, ML_HEADS, ML_QK_DIM)
    v = v.astype(f32).reshape(B, NC, BLOCK, ML_HEADS, ML_V_DIM)
    vm = valid[None, :, None]
    log_i = jnp.where(vm, i_pre.astype(f32), NEG)
    log_f = jnp.where(vm, jax.nn.log_sigmoid(f_pre.astype(f32)), 0.0)
    log_i = log_i.reshape(B, NC, BLOCK, ML_HEADS).transpose(0, 1, 3, 2)
    log_f = log_f.reshape(B, NC, BLOCK, ML_HEADS).transpose(0, 1, 3, 2)
    b = jnp.cumsum(log_f, axis=-1)
    b_last = b[..., -1]
    g = b_last[..., None] - b + log_i
    m_loc = jnp.max(g, axis=-1)
    w = jnp.exp(g - m_loc[..., None])
    C_loc = jnp.einsum('bnhl,bnlhk,bnlhv->bnhkv', w, k, v)
    n_loc = jnp.einsum('bnhl,bnlhk->bnhk', w, k)

    def step(carry, xs):
        C, n, m = carry
        bl, ml, Cl, nl = xs
        m_new = jnp.maximum(bl + m, ml)
        a = jnp.exp(bl + m - m_new)
        c = jnp.exp(ml - m_new)
        C_new = a[..., None, None] * C + c[..., None, None] * Cl
        n_new = a[..., None] * n + c[..., None] * nl
        return (C_new, n_new, m_new), (C, n, m)

    init = (jnp.zeros((B, ML_HEADS, ML_QK_DIM, ML_V_DIM), f32),
            jnp.zeros((B, ML_HEADS, ML_QK_DIM), f32),
            jnp.zeros((B, ML_HEADS), f32))
    xs = (jnp.moveaxis(b_last, 1, 0), jnp.moveaxis(m_loc, 1, 0),
          jnp.moveaxis(C_loc, 1, 0), jnp.moveaxis(n_loc, 1, 0))
    _, (C_prev, n_prev, m_prev) = lax.scan(step, init, xs)
    C_prev = jnp.moveaxis(C_prev, 0, 1)
    n_prev = jnp.moveaxis(n_prev, 0, 1)
    m_prev = jnp.moveaxis(m_prev, 0, 1)
    D = b[..., :, None] - b[..., None, :] + log_i[..., None, :]
    causal = jnp.tril(jnp.ones((BLOCK, BLOCK), dtype=bool))
    D = jnp.where(causal, D, -jnp.inf)
    inter_log = b + m_prev[..., None]
    m_t = jnp.maximum(inter_log, jnp.max(D, axis=-1))
    S = jnp.einsum('bnthk,bnshk->bnhts', q, k) * jnp.exp(D - m_t[..., None])
    a = jnp.exp(inter_log - m_t)
    a_t = a.transpose(0, 1, 3, 2)[..., None]
    num = (jnp.einsum('bnhts,bnshv->bnthv', S, v)
           + a_t * jnp.einsum('bnthk,bnhkv->bnthv', q, C_prev))
    den = jnp.sum(S, axis=-1) + a * jnp.einsum('bnthk,bnhk->bnht', q, n_prev)
    den = jnp.maximum(jnp.abs(den), jnp.exp(-m_t))
    h = num / den.transpose(0, 1, 3, 2)[..., None]
    return h.reshape(B, LP, ML_HEADS, ML_V_DIM)


def setup_inputs(seed: int = 0) -> dict:
    key = jax.random.key(seed)
    ks = jax.random.split(key, 16)
    f32 = jnp.float32
    nrm = lambda k, shape, s: jax.random.normal(k, shape, f32) * s
    return {
        "x": nrm(ks[0], (BATCH, SEQ, D_MODEL), 1.0),
        "meta_tokens": nrm(ks[1], (N_META, D_MODEL), 1.0),
        "w_in": nrm(ks[2], (DEPTH, D_MODEL, IN_COLS), D_MODEL ** -0.5),
        "conv_w": nrm(ks[3], (DEPTH, CONV_WIDTH, 2 * ML_QK_WIDTH), CONV_WIDTH ** -0.5),
        "conv_b": nrm(ks[4], (DEPTH, 2 * ML_QK_WIDTH), 0.01),
        "b_igate": nrm(ks[5], (DEPTH, ML_HEADS), 0.1),
        "b_fgate": jnp.linspace(3.0, 6.0, ML_HEADS, dtype=f32)[None] + nrm(ks[6], (DEPTH, ML_HEADS), 0.1),
        "attn_sinks": nrm(ks[7], (DEPTH, ATT_HEADS), 0.5),
        "rel_bias": nrm(ks[8], (N_BUCKETS, ATT_HEADS), 0.5),
        "mh_norm": 1.0 + nrm(ks[9], (DEPTH, ML_WIDTH), 0.02),
        "w_out": nrm(ks[10], (DEPTH, MIX_WIDTH, D_MODEL), MIX_WIDTH ** -0.5),
        "norm_mix": 1.0 + nrm(ks[11], (DEPTH, D_MODEL), 0.02),
        "norm_mlp": 1.0 + nrm(ks[12], (DEPTH, D_MODEL), 0.02),
        "w_up": nrm(ks[13], (DEPTH, D_MODEL, D_FF), D_MODEL ** -0.5),
        "w_down": nrm(ks[14], (DEPTH, D_FF, D_MODEL), D_FF ** -0.5),
        "norm_final": 1.0 + nrm(ks[15], (D_MODEL,), 0.02),
    }


def reference(x, meta_tokens, w_in, conv_w, conv_b, b_igate, b_fgate, attn_sinks,
              rel_bias, mh_norm, w_out, norm_mix, norm_mlp, w_up, w_down, norm_final):
    B, S, D = x.shape
    LP = BLOCK + S
    NB = LP // BLOCK
    meta = jnp.broadcast_to(meta_tokens[None].astype(x.dtype), (B, N_META, D))
    h = jnp.concatenate([jnp.zeros((B, N_PAD, D), x.dtype), meta, x], axis=1)
    valid = jnp.arange(LP) >= N_PAD
    bias_band, mask_band, bias_meta, mask_meta = positional_tables(rel_bias, NB)
    offs = np.cumsum(IN_SIZES)[:-1].tolist()

    for l in range(DEPTH):
        u = rmsnorm(h, norm_mix[l])
        proj = u @ w_in[l]
        a_q, a_k, a_v, m_q, m_k, m_v, m_o, m_i, m_f = jnp.split(proj, offs, axis=-1)
        att = swa_sink_attention(a_q, a_k, a_v, attn_sinks[l],
                                 bias_band, mask_band, bias_meta, mask_meta)
        qk = causal_conv_silu(jnp.concatenate([m_q, m_k], axis=-1), conv_w[l], conv_b[l])
        m_q, m_k = qk[..., :ML_QK_WIDTH], qk[..., ML_QK_WIDTH:]
        i_pre = GATE_SOFTCAP * jnp.tanh((m_i + b_igate[l]) / GATE_SOFTCAP)
        f_pre = GATE_SOFTCAP * jnp.tanh((m_f + b_fgate[l]) / GATE_SOFTCAP)
        hm = mlstm_chunkwise(m_q, m_k, m_v, i_pre, f_pre, valid)
        hm = hm * lax.rsqrt(jnp.mean(hm * hm, axis=-1, keepdims=True) + EPS)
        hm = hm.reshape(B, LP, ML_WIDTH) * mh_norm[l].astype(jnp.float32)
        hm = (hm * jax.nn.sigmoid(m_o.astype(jnp.float32))).astype(x.dtype)
        mix = jnp.concatenate([att.astype(x.dtype), hm], axis=-1)
        h = h + mix @ w_out[l]
        u = rmsnorm(h, norm_mlp[l])
        h = h + jnp.square(jax.nn.relu(u @ w_up[l])) @ w_down[l]

    h = rmsnorm(h, norm_final)
    return h[:, BLOCK:]
```

```cpp
#ifndef MK_N_LAUNCHES
#define MK_N_LAUNCHES 1
#endif
#include <hip/hip_runtime.h>
#include <cstdio>
#include <cstdint>
namespace pg8 {
#define PG8_LAS __attribute__((address_space(3)))
typedef unsigned short bf16_t;
typedef short bf16x8 __attribute__((ext_vector_type(8)));
typedef float f32x4 __attribute__((ext_vector_type(4)));
typedef unsigned u32x4 __attribute__((ext_vector_type(4)));
constexpr int BM = 256, BK = 64, HALF = 128, HTB = HALF * BK * 2  , STAGE_BYTES = 8 * HTB, NXCD = 8, WGM = 8;

__host__ __device__ __forceinline__ int lds_byte(int r, int c) { const int st = (r >> 4) * 2 + (c >> 5), rr = r & 15, cc = c & 31, ob = rr * 64 + cc * 2; return st * 1024 + (ob ^ (((ob >> 9) & 1) << 5)); }
__host__ __device__ __forceinline__ void stage_rc(int b, int& R, int& C) { const int st = b / 1024, sb = b % 1024, swz = sb ^ (((sb >> 9) & 1) << 5); R = (st >> 1) * 16 + swz / 64; C = (st & 1) * 32 + (swz % 64) / 2; }
__host__ __device__ __forceinline__ int perm32(int rho) { const int n = rho >> 4, i = rho & 15; return 8 * (i >> 2) + 4 * n + (i & 3); }

struct Unit { int pm, pn; };
struct Gemm { const bf16_t* A; const bf16_t* Bt; int M, N, K; };

struct StaticOrder {
    int nM, nN, nwg, G, c;
    __host__ __device__ void init(int M, int N, int G_, int c_) { nM = M / BM; nN = N / BM; nwg = nM * nN; G = G_; c = c_; }
    __host__ __device__ bool next(int i, Unit& u) const {
        const long L = (long)i * G + c; if (L >= nwg) return false;
        int wgid = (int)L; { const int q = nwg / NXCD, r = nwg % NXCD, xcd = wgid % NXCD, off = wgid / NXCD; wgid = (xcd < r ? xcd * (q + 1) : r * (q + 1) + (xcd - r) * q) + off; }
        const int nig = WGM * nN, gid = wgid / nig, fm = gid * WGM, gsz = (nM - fm) < WGM ? (nM - fm) : WGM;
        u.pm = fm + ((wgid % nig) % gsz); u.pn = (wgid % nig) / gsz; return true;
    }
    __device__ __forceinline__ void a_ready(const Unit&) const {}
    __device__ __forceinline__ void done(const Unit&) const {}
};

__device__ __forceinline__ unsigned cvt_pk_bf16(float lo, float hi) { unsigned r; asm volatile("v_cvt_pk_bf16_f32 %0, %1, %2" : "=v"(r) : "v"(lo), "v"(hi)); return r; }

struct EpiBf16RowScale {
    static constexpr bool PERM = true, AFTER_DRAIN = false;
    bf16_t* O; int ldc; const float* rowscale;
    __device__ __forceinline__ void operator()(const f32x4 (&acc)[2][2][4][2], const Unit& u, int wr, int wc, int fr, int fq) const {
        const int row0 = u.pm * BM + wr * 64 + fr; const int col0 = u.pn * BM + wc * 32 + 8 * fq;
#pragma unroll
        for (int ai = 0; ai < 2; ++ai)
#pragma unroll
            for (int m = 0; m < 4; ++m) { const int row = row0 + ai * HALF + m * 16; const float sc = rowscale[row]; bf16_t* rowp = O + (size_t)row * ldc + col0;
#pragma unroll
                for (int bj = 0; bj < 2; ++bj) { f32x4 v0 = acc[ai][bj][m][0] * sc, v1 = acc[ai][bj][m][1] * sc;
                    u32x4 w; w.x = cvt_pk_bf16(v0[0], v0[1]); w.y = cvt_pk_bf16(v0[2], v0[3]); w.z = cvt_pk_bf16(v1[0], v1[1]); w.w = cvt_pk_bf16(v1[2], v1[3]);
                    *(u32x4*)(rowp + bj * HALF) = w; } }
    }
};
struct EpiSqRelu {
    static constexpr bool PERM = true, AFTER_DRAIN = false;
    bf16_t* O; int ldc; const float* ssq; float inv_d, eps;
    __device__ __forceinline__ void operator()(const f32x4 (&acc)[2][2][4][2], const Unit& u, int wr, int wc, int fr, int fq) const {
        const int row0 = u.pm * BM + wr * 64 + fr; const int col0 = u.pn * BM + wc * 32 + 8 * fq;
#pragma unroll
        for (int ai = 0; ai < 2; ++ai)
#pragma unroll
            for (int m = 0; m < 4; ++m) { const int row = row0 + ai * HALF + m * 16;
                const f32x4* sp = (const f32x4*)(ssq + (size_t)row * 32); f32x4 s4 = sp[0];
#pragma unroll
                for (int j = 1; j < 8; ++j) s4 = s4 + sp[j];
                const float sc = 1.0f / sqrtf(((s4[0] + s4[1]) + (s4[2] + s4[3])) * inv_d + eps);
                bf16_t* rowp = O + (size_t)row * ldc + col0;
#pragma unroll
                for (int bj = 0; bj < 2; ++bj) { f32x4 v0 = acc[ai][bj][m][0] * sc, v1 = acc[ai][bj][m][1] * sc;
#pragma unroll
                    for (int e = 0; e < 4; ++e) { const float a = fmaxf(v0[e], 0.f), b = fmaxf(v1[e], 0.f); v0[e] = a * a; v1[e] = b * b; }
                    u32x4 w; w.x = cvt_pk_bf16(v0[0], v0[1]); w.y = cvt_pk_bf16(v0[2], v0[3]); w.z = cvt_pk_bf16(v1[0], v1[1]); w.w = cvt_pk_bf16(v1[2], v1[3]);
                    *(u32x4*)(rowp + bj * HALF) = w; } }
    }
};
struct EpiResid {
    static constexpr bool PERM = false, AFTER_DRAIN = false;
    const float* resid; float* out; bf16_t* outb; float* ssq; int ldc;
    __device__ __forceinline__ void operator()(const f32x4 (&acc)[2][2][4][2], const Unit& u, int wr, int wc, int fr, int fq) const {
        const int row0 = u.pm * BM + wr * 64 + fr; const int col0 = u.pn * BM + wc * 32 + 4 * fq;
        typedef unsigned u32x2v __attribute__((ext_vector_type(2)));
#pragma unroll
        for (int ai = 0; ai < 2; ++ai)
#pragma unroll
            for (int m = 0; m < 4; ++m) { const int row = row0 + ai * HALF + m * 16; const size_t off = (size_t)row * ldc + col0; float s = 0.f;
#pragma unroll
                for (int bj = 0; bj < 2; ++bj)
#pragma unroll
                    for (int n = 0; n < 2; ++n) { const size_t o2 = off + bj * HALF + n * 16; const f32x4 r = *(const f32x4*)(resid + o2); const f32x4 o = r + acc[ai][bj][m][n];
                        *(f32x4*)(out + o2) = o; s += (o[0] * o[0] + o[1] * o[1]) + (o[2] * o[2] + o[3] * o[3]);
                        if (outb) { u32x2v w; w.x = cvt_pk_bf16(o[0], o[1]); w.y = cvt_pk_bf16(o[2], o[3]); *(u32x2v*)(outb + o2) = w; } }
                if (ssq) { s += __shfl_xor(s, 16); s += __shfl_xor(s, 32); if (fq == 0) ssq[(size_t)row * 32 + u.pn * 4 + wc] = s; }
                if (m & 1) asm volatile("" ::: "memory"); }
    }
};

template <class Epi, class Sched, bool ALIGN_EPI = false, bool SP2 = false>
__device__ __forceinline__ void gemm_phase(PG8_LAS unsigned char* lds, const Gemm g, const Sched& S, const Epi& E) {
    const int tid = threadIdx.x, wid = __builtin_amdgcn_readfirstlane(tid >> 6), lane = tid & 63, wr = wid >> 2, wc = wid & 3, fr = lane & 15, fq = lane >> 4;
    const int K = g.K, nt = K / BK;
    unsigned voffA[2], voffB[2];
#pragma unroll
    for (int i = 0; i < 2; ++i) { int R, C; stage_rc(tid * 16 + i * 8192, R, C); const int Rb = Epi::PERM ? ((R & ~31) + perm32(R & 31)) : R;
        voffA[i] = (unsigned)(R * K + C) * 2u; voffB[i] = (unsigned)(Rb * K + C) * 2u; }
    const size_t kstep = (size_t)(BK * 2);
    const size_t hstep = (size_t)HALF * K * 2;
    const size_t tstep = 2 * hstep;
    const unsigned ldsw = (unsigned)wid * 1024u;
    const int aoff = lds_byte(wr * 64 + fr, fq * 8), boff = lds_byte(wc * 32 + fr, fq * 8);
#define PG8_SA(b, h) (((b) * 2 + (h)) * HTB)
#define PG8_SB(b, h) ((4 + (b) * 2 + (h)) * HTB)
#define PG8_STAGE(bufoff, gbase, voff) do { _Pragma("unroll") for (int _i = 0; _i < 2; ++_i) \
        __builtin_amdgcn_global_load_lds((const unsigned*)((const char*)(gbase) + (voff)[_i]), (PG8_LAS unsigned*)(lds + (bufoff) + ldsw + _i * 8192), 16, 0, 0); } while (0)
#define PG8_LDA(dst, b, h) do { _Pragma("unroll") for (int m = 0; m < 4; ++m) _Pragma("unroll") for (int k = 0; k < 2; ++k) dst[m][k] = *(const PG8_LAS bf16x8*)(lds + PG8_SA(b, h) + aoff + m * 2048 + k * 1024); } while (0)
#define PG8_LDB(dst, b, h) do { _Pragma("unroll") for (int n = 0; n < 2; ++n) _Pragma("unroll") for (int k = 0; k < 2; ++k) dst[n][k] = *(const PG8_LAS bf16x8*)(lds + PG8_SB(b, h) + boff + n * 2048 + k * 1024); } while (0)
#define PG8_MMA(ai, bj, At, Bt) do { __builtin_amdgcn_s_setprio(1); _Pragma("unroll") for (int m = 0; m < 4; ++m) _Pragma("unroll") for (int n = 0; n < 2; ++n) _Pragma("unroll") for (int k = 0; k < 2; ++k) \
        acc[ai][bj][m][n] = __builtin_amdgcn_mfma_f32_16x16x32_bf16(Bt[n][k], At[m][k], acc[ai][bj][m][n], 0, 0, 0); __builtin_amdgcn_s_setprio(0); } while (0)
#define PG8_WAIT_V(n) asm volatile("s_waitcnt vmcnt(" #n ")" ::: "memory")
#define PG8_WAIT_L(n) asm volatile("s_waitcnt lgkmcnt(" #n ")" ::: "memory")
#define PG8_BAR __builtin_amdgcn_s_barrier()
#define PG8_SCHED __builtin_amdgcn_sched_barrier(0)
    Unit cur, nxt; int ui = 0;
    if (!S.next(0, cur)) return;
    f32x4 acc[2][2][4][2];
#pragma unroll
    for (int a = 0; a < 2; ++a)
#pragma unroll
        for (int b = 0; b < 2; ++b)
#pragma unroll
            for (int m = 0; m < 4; ++m)
#pragma unroll
                for (int n = 0; n < 2; ++n) acc[a][b][m][n] = (f32x4){0.f, 0.f, 0.f, 0.f};
    bf16x8 At[4][2], B0[2][2], B1[2][2];
    const char* cA = (const char*)g.A + (size_t)cur.pm * tstep; const char* cB = (const char*)g.Bt + (size_t)cur.pn * tstep;
    S.a_ready(cur);
    if constexpr (SP2) {
        PG8_STAGE(PG8_SB(0, 0), cB, voffB); PG8_STAGE(PG8_SB(0, 1), cB + hstep, voffB); PG8_STAGE(PG8_SA(0, 0), cA, voffA); PG8_STAGE(PG8_SA(0, 1), cA + hstep, voffA);
        if (wr == 1) PG8_BAR;
        PG8_WAIT_V(2); PG8_BAR;
        PG8_STAGE(PG8_SB(1, 0), cB + kstep, voffB); PG8_STAGE(PG8_SA(1, 0), cA + kstep, voffA); PG8_STAGE(PG8_SB(1, 1), cB + hstep + kstep, voffB);
        PG8_WAIT_V(6); PG8_BAR;
    } else {
        PG8_STAGE(PG8_SB(0, 0), cB, voffB); PG8_STAGE(PG8_SA(0, 0), cA, voffA); PG8_STAGE(PG8_SB(0, 1), cB + hstep, voffB); PG8_STAGE(PG8_SA(0, 1), cA + hstep, voffA);
        if (wr == 1) PG8_BAR;
        PG8_WAIT_V(4); PG8_BAR;
        PG8_STAGE(PG8_SB(1, 0), cB + kstep, voffB); PG8_STAGE(PG8_SA(1, 0), cA + kstep, voffA); PG8_STAGE(PG8_SB(1, 1), cB + hstep + kstep, voffB);
        PG8_WAIT_V(6); PG8_BAR;
    }
    for (;;) {
        const bool has_next = S.next(ui + 1, nxt);
        const char* nA = has_next ? (const char*)g.A + (size_t)nxt.pm * tstep : cA; const char* nB = has_next ? (const char*)g.Bt + (size_t)nxt.pn * tstep : cB;
        for (int t = 0; t < nt; t += 2) {
            const bool last = (t == nt - 2);
            const char* a1 = cA + (size_t)(t + 1) * kstep;
            const char* a2 = last ? nA : cA + (size_t)(t + 2) * kstep; const char* b2 = last ? nB : cB + (size_t)(t + 2) * kstep;
            const char* a3 = a2 + kstep; const char* b3 = b2 + kstep;
            if (last && has_next) S.a_ready(nxt);
            if constexpr (SP2) {
            PG8_LDB(B0, 0, 0); PG8_LDB(B1, 0, 1); PG8_SCHED; PG8_LDA(At, 0, 0); PG8_STAGE(PG8_SA(1, 1), a1 + hstep, voffA);
            PG8_WAIT_V(8); PG8_WAIT_L(0); PG8_BAR; PG8_MMA(0, 0, At, B0); PG8_MMA(0, 1, At, B1); PG8_BAR; PG8_SCHED;
            PG8_LDA(At, 0, 1); PG8_STAGE(PG8_SB(0, 0), b2, voffB); PG8_STAGE(PG8_SB(0, 1), b2 + hstep, voffB); PG8_STAGE(PG8_SA(0, 0), a2, voffA);
            PG8_WAIT_V(8); PG8_WAIT_L(0); PG8_BAR; PG8_MMA(1, 0, At, B0); PG8_MMA(1, 1, At, B1); PG8_BAR; PG8_SCHED;
            PG8_LDB(B0, 1, 0); PG8_LDB(B1, 1, 1); PG8_SCHED; PG8_LDA(At, 1, 0); PG8_STAGE(PG8_SA(0, 1), a2 + hstep, voffA);
            PG8_WAIT_V(8); PG8_WAIT_L(0); PG8_BAR; PG8_MMA(0, 0, At, B0); PG8_MMA(0, 1, At, B1); PG8_BAR; PG8_SCHED;
            PG8_LDA(At, 1, 1); PG8_STAGE(PG8_SB(1, 0), b3, voffB); PG8_STAGE(PG8_SB(1, 1), b3 + hstep, voffB); PG8_STAGE(PG8_SA(1, 0), a3, voffA);
            PG8_WAIT_V(8); PG8_WAIT_L(0); PG8_BAR; PG8_MMA(1, 0, At, B0); PG8_MMA(1, 1, At, B1); PG8_BAR; PG8_SCHED;
            } else {
            PG8_LDB(B0, 0, 0); PG8_SCHED; PG8_LDA(At, 0, 0); PG8_STAGE(PG8_SA(1, 1), a1 + hstep, voffA);
            PG8_WAIT_L(8); PG8_BAR; PG8_WAIT_L(0); PG8_MMA(0, 0, At, B0); PG8_BAR; PG8_SCHED;
            PG8_LDB(B1, 0, 1); PG8_STAGE(PG8_SB(0, 0), b2, voffB);
            PG8_BAR; PG8_WAIT_L(0); PG8_MMA(0, 1, At, B1); PG8_BAR;
            PG8_LDA(At, 0, 1); PG8_STAGE(PG8_SA(0, 0), a2, voffA);
            PG8_BAR; PG8_WAIT_L(0); PG8_MMA(1, 0, At, B0); PG8_BAR; PG8_SCHED;
            PG8_STAGE(PG8_SB(0, 1), b2 + hstep, voffB);
            PG8_WAIT_V(6); PG8_BAR; PG8_MMA(1, 1, At, B1); PG8_BAR;
            PG8_LDB(B0, 1, 0); PG8_SCHED; PG8_LDA(At, 1, 0); PG8_STAGE(PG8_SA(0, 1), a2 + hstep, voffA);
            PG8_WAIT_L(8); PG8_BAR; PG8_WAIT_L(0); PG8_MMA(0, 0, At, B0); PG8_BAR; PG8_SCHED;
            PG8_LDB(B1, 1, 1); PG8_STAGE(PG8_SB(1, 0), b3, voffB);
            PG8_BAR; PG8_WAIT_L(0); PG8_MMA(0, 1, At, B1); PG8_BAR;
            PG8_LDA(At, 1, 1); PG8_STAGE(PG8_SA(1, 0), a3, voffA);
            PG8_BAR; PG8_WAIT_L(0); PG8_MMA(1, 0, At, B0); PG8_BAR; PG8_SCHED;
            PG8_STAGE(PG8_SB(1, 1), b3 + hstep, voffB);
            PG8_WAIT_V(6); PG8_BAR; PG8_MMA(1, 1, At, B1); PG8_BAR;
            }
        }
        if constexpr (ALIGN_EPI) { if (wr == 0) PG8_BAR; }
        if constexpr (!Epi::AFTER_DRAIN) { E(acc, cur, wr, wc, fr, fq); S.done(cur); }
        if (!has_next) break;
#pragma unroll
        for (int a = 0; a < 2; ++a)
#pragma unroll
            for (int b = 0; b < 2; ++b)
#pragma unroll
                for (int m = 0; m < 4; ++m)
#pragma unroll
                    for (int n = 0; n < 2; ++n) acc[a][b][m][n] = (f32x4){0.f, 0.f, 0.f, 0.f};
        cur = nxt; cA = nA; cB = nB; ++ui;
        if constexpr (ALIGN_EPI) { if (wr == 1) PG8_BAR; }
    }
    PG8_WAIT_V(0);
    if constexpr (!ALIGN_EPI) { if (wr == 0) PG8_BAR; }
    PG8_BAR;
    if constexpr (Epi::AFTER_DRAIN) { E.fused(acc, cur, wr, wc, fr, fq, lds, wid, lane); S.done(cur); }
#undef PG8_SA
#undef PG8_SB
#undef PG8_STAGE
#undef PG8_LDA
#undef PG8_LDB
#undef PG8_MMA
#undef PG8_WAIT_V
#undef PG8_WAIT_L
#undef PG8_BAR
#undef PG8_SCHED
}
}
#define GAS __attribute__((address_space(1)))
#define LAS __attribute__((address_space(3)))
typedef unsigned short bf16;
typedef unsigned v4u __attribute__((ext_vector_type(4)));
typedef float f32x4 __attribute__((ext_vector_type(4)));
typedef short bf16x8 __attribute__((ext_vector_type(8)));
typedef GAS unsigned gu32;
typedef GAS unsigned long long gu64;
#define RLX_AGENT __ATOMIC_RELAXED, __HIP_MEMORY_SCOPE_AGENT
#define LDS_WAIT() asm volatile("s_waitcnt lgkmcnt(0)" ::: "memory")
#define VM_WAIT() asm volatile("s_waitcnt vmcnt(0)" ::: "memory")
__device__ __forceinline__ unsigned long long rt() { return __builtin_amdgcn_s_memrealtime(); }
__device__ __forceinline__ unsigned f2bf(float f) { unsigned u = __builtin_bit_cast(unsigned, f); return (u + 0x7fffu + ((u >> 16) & 1u)) >> 16; }
__device__ __forceinline__ unsigned pk2(float lo, float hi) { return f2bf(lo) | (f2bf(hi) << 16); }

#define XB_TMO      128
#define XB_XCNT(j)  (256  + 64 * (j))
#define XB_XSUB(j)  (1280 + 64 * (j))
#define XB_XGEN(j)  (2304 + 64 * (j))
#define XB_TOP      3328
#define XB_TOPGEN   3392
#define XCD_BAR_WORDS 3456
#define XB_SPIN_CAP (1u << 18)

__device__ __forceinline__ unsigned xb_ld(unsigned* p)              { return __hip_atomic_load(p, __ATOMIC_RELAXED, __HIP_MEMORY_SCOPE_AGENT); }
__device__ __forceinline__ unsigned xb_add(unsigned* p, unsigned v) { return __hip_atomic_fetch_add(p, v, __ATOMIC_RELAXED, __HIP_MEMORY_SCOPE_AGENT); }
__device__ __forceinline__ unsigned xb_xcc_id() { return (unsigned)__builtin_amdgcn_s_getreg((3 << 11) | 20) & 0xFu; }
#define XB_SPIN(cond, bar) do { unsigned _sp = 0; while (cond) { __builtin_amdgcn_s_sleep(1); \
    if ((++_sp & 255u) == 0u) { if (xb_ld(&(bar)[XB_TMO])) break; if (_sp > XB_SPIN_CAP) { atomicAdd(&(bar)[XB_TMO], 1u); break; } } } } while (0)

struct XcdBarrier {
    unsigned* bar; unsigned x;
    volatile LAS unsigned* st;
};

__device__ __forceinline__ XcdBarrier xcd_barrier_post(unsigned* bar, volatile LAS unsigned* st) {
    XcdBarrier b; b.bar = bar; b.x = xb_xcc_id(); b.st = st;
    if (threadIdx.x == 0) (void)xb_add(&bar[XB_XCNT(b.x)], 1u);
    return b;
}
__device__ __forceinline__ void xcd_barrier_complete(unsigned* bar, unsigned x, unsigned& nloc, unsigned& nx) {
    const unsigned G = gridDim.x * gridDim.y * gridDim.z;
    unsigned sum, cnt, mine, sp = 0u;
    for (;;) {
        sum = 0u; cnt = 0u; mine = 0u;
#pragma unroll
        for (unsigned j = 0; j < 16; ++j) { const unsigned c = xb_ld(&bar[XB_XCNT(j)]); sum += c; cnt += (c > 0u) ? 1u : 0u; mine = (j == x) ? c : mine; }
        if (sum == G) break;
        __builtin_amdgcn_s_sleep(1);
        if ((++sp & 255u) == 0u) { if (xb_ld(&bar[XB_TMO])) break; if (sp > XB_SPIN_CAP) { atomicAdd(&bar[XB_TMO], 1u); break; } }
    }
    nloc = mine > 0u ? mine : 1u; nx = cnt > 0u ? cnt : 1u;
}

__device__ __forceinline__ void xcd_barrier(const XcdBarrier& b) {
    asm volatile("s_waitcnt vmcnt(0)" ::: "memory");
    __syncthreads();
    if (threadIdx.x == 0) {
        unsigned* bar = b.bar;
        __builtin_amdgcn_s_waitcnt(0);
        unsigned nloc = b.st[0], nx = b.st[1];
        if (nloc == 0u) { xcd_barrier_complete(bar, b.x, nloc, nx); b.st[0] = nloc; b.st[1] = nx; }
        const unsigned old = xb_add(&bar[XB_XSUB(b.x)], 1u);
        const unsigned gen = old / nloc;
        if (old + 1u == (gen + 1u) * nloc) {
            __builtin_amdgcn_fence(__ATOMIC_RELEASE, "agent");
            asm volatile("s_waitcnt vmcnt(0)" ::: "memory");
            const unsigned og = xb_add(&bar[XB_TOP], 1u);
            const unsigned tg = og / nx;
            if (og + 1u == (tg + 1u) * nx) xb_add(&bar[XB_TOPGEN], 1u);
            else XB_SPIN(xb_ld(&bar[XB_TOPGEN]) == tg, bar);
            __builtin_amdgcn_fence(__ATOMIC_ACQUIRE, "agent");
            xb_add(&bar[XB_XGEN(b.x)], 1u);
            asm volatile("s_waitcnt vmcnt(0)" ::: "memory");
        } else {
            XB_SPIN(xb_ld(&bar[XB_XGEN(b.x)]) == gen, bar);
            __builtin_amdgcn_fence(__ATOMIC_ACQUIRE, "agent");
            asm volatile("s_waitcnt vmcnt(0)" ::: "memory");
        }
    }
    __syncthreads();
}
constexpr int NWAVES = 8, NTHREADS = 512;
constexpr int BATCH = 2, SEQ = 4096, DM = 2048, NBLK = 33, BLK = 128, NMETA = 16, NPADR = 112;
constexpr int MR = BATCH * SEQ;
constexpr int META0 = MR;
constexpr int MROWS = 8448;
constexpr int NPROJ = 4608, INCOLS = 4616, DFF = 8192;
constexpr int C_AQ = 0, C_AK = 1024, C_AV = 1280, C_MQ = 1536, C_MK = 2048, C_MV = 2560, C_MO = 3584;
constexpr float EPS = 1e-6f, NEGBIG = -1e30f;
constexpr int NCH = BATCH * NBLK * 4;
constexpr int NIT = BATCH * 32 * 4;

constexpr size_t MiB = 1u << 20;
constexpr size_t WS_CTL = 0, CTL_ZERO_BYTES = 1 * MiB;
constexpr size_t WS_SM = 1 * MiB;
constexpr size_t WS_WUP = 8 * MiB, WS_WDN = 40 * MiB;
constexpr size_t WS_XB = 72 * MiB;
constexpr size_t WS_ACT = 105 * MiB;
constexpr size_t WS_WIN = 105 * MiB, WS_WOUT = 123 * MiB, WS_MIX = 131 * MiB, WS_PROJ = 163 * MiB;
constexpr size_t WS_KC = 238 * MiB, WS_QC = 247 * MiB;
constexpr size_t WS_END = 256 * MiB;
static_assert(WS_PROJ + (size_t)MROWS * NPROJ * 2 <= WS_KC && WS_QC + (size_t)MROWS * 512 * 2 <= WS_END, "ws map");
constexpr size_t DO_CLOC = 0, DO_CPREV = 33 * MiB, DO_PBUF = 50 * MiB;
constexpr int SM_RSTDX = 0, SM_GI = SM_RSTDX + MROWS, SM_GF = SM_GI + MROWS * 4, SM_BCS = SM_GF + MROWS * 4, SM_LI = SM_BCS + NCH * 128, SM_WL = SM_LI + NCH * 128,
              SM_BLAST = SM_WL + NCH * 128, SM_MLOC = SM_BLAST + NCH, SM_MPREV = SM_MLOC + NCH, SM_NLOC = SM_MPREV + NCH, SM_NPREV = SM_NLOC + NCH * 128,
              SM_MT = SM_NPREV + NCH * 128, SM_AT = SM_MT + NCH * 128, SM_SSQ1 = ((SM_AT + NCH * 128 + 63) / 64) * 64, SM_END = SM_SSQ1 + MR * 32;
static_assert((size_t)SM_END * 4 <= 7 * MiB, "small arrays");
constexpr int CW_BAR = 4096;

constexpr int RING_OFF = 0, RING_BYTES = 131072;
constexpr int SCR_BYTES = 139264;
constexpr int LDSCTL_OFF = SCR_BYTES, MISC_OFF = LDSCTL_OFF + 320;
constexpr int LDS_BYTES = 147456;
static_assert(MISC_OFF + 128 <= LDS_BYTES, "LDS map");

__device__ __forceinline__ float bf2f(unsigned short h) { return __uint_as_float((unsigned)h << 16); }
__device__ __forceinline__ float wave_sum(float v) {
#pragma unroll
    for (int o = 1; o < 64; o <<= 1) v += __shfl_xor(v, o);
    return v;
}
__device__ __forceinline__ int t5_bucket(int d) {
    if (d < 16) return d;
    return 16 + (d >= 19) + (d >= 21) + (d >= 24) + (d >= 27) + (d >= 31) + (d >= 35) + (d >= 40) + (d >= 46) + (d >= 52) + (d >= 59) + (d >= 67) + (d >= 77) + (d >= 87) + (d >= 99) + (d >= 113);
}
__device__ __forceinline__ int row_of(int b, int p) { return p >= 128 ? b * SEQ + p - 128 : (p >= NPADR ? META0 + p - NPADR : -1); }

struct Frame {
    LAS unsigned char* lds;
    volatile LAS unsigned* MISC;
    gu32* ctl;
    int tid, lane, wave, G;
    const float *x, *meta, *w_in, *conv_w, *conv_b, *b_ig, *b_fg, *sinks, *rel_bias, *mh_norm, *w_out, *norm_mix, *norm_mlp, *w_up, *w_down, *norm_final;
    float* out; float* sm;
    bf16 *Wup, *Wdn, *XB, *ACT, *Win, *Wout, *MIX, *PROJ, *KC, *QC;
    float* CLOC; bf16* CPREV; bf16* PBUF;
};

__device__ __forceinline__ void p0_transpose_item(const float* W, int ldw, int K, const float* g, bf16* WT, LAS float* scr, int kb, int nb, int lane) {
    const int k0 = 64 * kb, n0 = 64 * nb;
#pragma unroll 4
    for (int i = 0; i < 16; ++i) { const int kk = 4 * i + (lane >> 4), nn = (lane & 15) * 4;
        const f32x4 v = *(const GAS f32x4*)(W + (size_t)(k0 + kk) * ldw + n0 + nn); const float s = g ? g[k0 + kk] : 1.f;
        LAS float* d = scr + kk * 65 + nn; d[0] = v[0] * s; d[1] = v[1] * s; d[2] = v[2] * s; d[3] = v[3] * s; }
    LDS_WAIT(); asm volatile("" ::: "memory");
    const int c = lane >> 3;
#pragma unroll
    for (int j = 0; j < 8; ++j) { const int n = (lane & 7) + 8 * j; const LAS float* s = scr + (8 * c) * 65 + n;
        v4u o; o.x = pk2(s[0 * 65], s[1 * 65]); o.y = pk2(s[2 * 65], s[3 * 65]); o.z = pk2(s[4 * 65], s[5 * 65]); o.w = pk2(s[6 * 65], s[7 * 65]);
        *(GAS v4u*)(WT + (size_t)(n0 + n) * K + k0 + 8 * c) = o; }
    LDS_WAIT(); asm volatile("" ::: "memory");
}
__device__ __forceinline__ void p0_transposes(Frame& F, int lo_mat, int hi_mat, int gw, int NGW) {
    LAS float* scr = (LAS float*)(F.lds + F.wave * 16640);
    constexpr int I_IN = (DM / 64) * (NPROJ / 64), I_OUT = (DM / 64) * (DM / 64), I_UP = (DM / 64) * (DFF / 64), I_DN = (DFF / 64) * (DM / 64);
    const int i0 = lo_mat == 0 ? 0 : I_IN, i1 = hi_mat == 1 ? I_IN : I_IN + I_OUT + I_UP + I_DN;
    for (int it = i0 + gw; it < i1; it += NGW) {
        int r = it;
        if (r < I_IN) { p0_transpose_item(F.w_in, INCOLS, DM, F.norm_mix, F.Win, scr, r / (NPROJ / 64), r % (NPROJ / 64), F.lane); continue; } r -= I_IN;
        if (r < I_OUT) { p0_transpose_item(F.w_out, DM, DM, nullptr, F.Wout, scr, r / (DM / 64), r % (DM / 64), F.lane); continue; } r -= I_OUT;
        if (r < I_UP) { p0_transpose_item(F.w_up, DFF, DM, F.norm_mlp, F.Wup, scr, r / (DFF / 64), r % (DFF / 64), F.lane); continue; } r -= I_UP;
        p0_transpose_item(F.w_down, DM, DFF, nullptr, F.Wdn, scr, r / (DM / 64), r % (DM / 64), F.lane);
    }
}
__device__ __forceinline__ void p0_rows(Frame& F, int gw, int NGW) {
    LAS float* gwt = (LAS float*)F.lds;
    for (int i = F.tid; i < DM * 8; i += NTHREADS) { const int k = i >> 3, j = i & 7; gwt[i] = F.norm_mix[k] * F.w_in[(size_t)k * INCOLS + NPROJ + j]; }
    __syncthreads();
    for (int r = gw; r < MROWS; r += NGW) {
        GAS unsigned long long* o8 = (GAS unsigned long long*)(F.XB + (size_t)r * DM) + F.lane;
        if (r >= META0 + NMETA) {
#pragma unroll
            for (int j = 0; j < 8; ++j) o8[64 * j] = 0ull;
            if (F.lane == 0) F.sm[SM_RSTDX + r] = 0.f;
            continue; }
        const float* xrow = r < MR ? F.x + (size_t)r * DM : F.meta + (size_t)(r - META0) * DM;
        const GAS f32x4* xr = (const GAS f32x4*)xrow + F.lane;
        f32x4 v[8]; float s = 0.f;
#pragma unroll
        for (int j = 0; j < 8; ++j) { v[j] = xr[64 * j]; s += (v[j][0] * v[j][0] + v[j][1] * v[j][1]) + (v[j][2] * v[j][2] + v[j][3] * v[j][3]); }
        const float rstd = 1.0f / sqrtf(wave_sum(s) * (1.f / DM) + EPS);
        float g8[8];
#pragma unroll
        for (int q = 0; q < 8; ++q) g8[q] = 0.f;
#pragma unroll
        for (int j = 0; j < 8; ++j) {
            o8[64 * j] = (unsigned long long)pk2(v[j][0], v[j][1]) | ((unsigned long long)pk2(v[j][2], v[j][3]) << 32);
#pragma unroll
            for (int e = 0; e < 4; ++e) { const int k = 4 * (F.lane + 64 * j) + e; const LAS f32x4* t = (const LAS f32x4*)(gwt + k * 8); const f32x4 t0 = t[0], t1 = t[1]; const float xv = v[j][e];
                g8[0] += xv * t0[0]; g8[1] += xv * t0[1]; g8[2] += xv * t0[2]; g8[3] += xv * t0[3]; g8[4] += xv * t1[0]; g8[5] += xv * t1[1]; g8[6] += xv * t1[2]; g8[7] += xv * t1[3]; } }
#pragma unroll
        for (int q = 0; q < 8; ++q) g8[q] = wave_sum(g8[q]);
        if (F.lane == 0) F.sm[SM_RSTDX + r] = rstd;
        if (F.lane < 8) {
            float pre = 0.f;
#pragma unroll
            for (int q = 0; q < 8; ++q) pre = (F.lane == q) ? g8[q] : pre;
            pre *= rstd;
            const int hh = F.lane & 3;
            if (F.lane < 4) { F.sm[SM_GI + r * 4 + hh] = 15.0f * tanhf((pre + F.b_ig[hh]) * (1.0f / 15.0f)); }
            else { const float fp = 15.0f * tanhf((pre + F.b_fg[hh]) * (1.0f / 15.0f));
                   F.sm[SM_GF + r * 4 + hh] = fminf(fp, 0.f) - log1pf(expf(-fabsf(fp))); }
        }
    }
    __syncthreads();
}

__device__ __forceinline__ void s2a_conv(Frame& F, int gt, int NT) {
    for (int i = gt; i < (MR + NMETA) * 1024; i += NT) {
        const int R = i >> 10, c = i & 1023;
        float y = F.conv_b[c];
#pragma unroll
        for (int j = 0; j < 4; ++j) { const int back = 3 - j; int src;
            if (R < MR) { const int t = R & (SEQ - 1); src = (t - back >= 0) ? R - back : META0 + NMETA + (t - back); }
            else { const int m = R - META0; src = (m - back >= 0) ? R - back : -1; }
            if (src >= 0) y += F.conv_w[j * 1024 + c] * bf2f(F.PROJ[(size_t)src * NPROJ + C_MQ + c]); }
        const float sv = y / (1.0f + expf(-y));
        if (c < 512) F.QC[(size_t)R * 512 + c] = (bf16)f2bf(sv * 0.08838834764831845f); else F.KC[(size_t)R * 512 + c - 512] = (bf16)f2bf(sv);
    }
}
__device__ __forceinline__ void s2b_gates(Frame& F, int gt, int NT) {
    for (int ci = gt; ci < NCH; ci += NT) {
        const int h = ci & 3, n = (ci >> 2) % NBLK, b = (ci >> 2) / NBLK; float cum = 0.f;
        for (int l = 0; l < BLK; ++l) { const int row = row_of(b, n * BLK + l); const float lf = row >= 0 ? F.sm[SM_GF + row * 4 + h] : 0.f, li = row >= 0 ? F.sm[SM_GI + row * 4 + h] : NEGBIG;
            cum += lf; F.sm[SM_BCS + ci * 128 + l] = cum; F.sm[SM_LI + ci * 128 + l] = li; }
        float ml = -3.0e38f;
        for (int l = 0; l < BLK; ++l) ml = fmaxf(ml, cum - F.sm[SM_BCS + ci * 128 + l] + F.sm[SM_LI + ci * 128 + l]);
        for (int l = 0; l < BLK; ++l) F.sm[SM_WL + ci * 128 + l] = expf(cum - F.sm[SM_BCS + ci * 128 + l] + F.sm[SM_LI + ci * 128 + l] - ml);
        F.sm[SM_BLAST + ci] = cum; F.sm[SM_MLOC + ci] = ml;
    }
}
__device__ __forceinline__ void s2_attn(Frame& F, int gt, int NT) {
    for (int i = gt; i < MR * 16; i += NT) {
        const int hd = i >> 13, R = i & (MR - 1), b = R >> 12, t = R & (SEQ - 1), p = t + 128, kvh = hd >> 2;
        float q[64], o[64];
        { const bf16* qp = F.PROJ + (size_t)R * NPROJ + C_AQ + hd * 64;
#pragma unroll
          for (int d = 0; d < 64; ++d) { q[d] = bf2f(qp[d]) * 0.125f; o[d] = 0.f; } }
        float m = F.sinks[hd], l = 1.0f;
        const int nband = (t + 1 < 128) ? t + 1 : 128;
        for (int kk = 0; kk < nband + 16; ++kk) {
            int krow, dist;
            if (kk < nband) { dist = kk; krow = R - kk; } else { const int mi = kk - nband; krow = META0 + mi; dist = p - (NPADR + mi); }
            const bf16* kp = F.PROJ + (size_t)krow * NPROJ + C_AK + kvh * 64; const bf16* vp = F.PROJ + (size_t)krow * NPROJ + C_AV + kvh * 64;
            float s = 0.f;
#pragma unroll
            for (int d = 0; d < 64; ++d) s += q[d] * bf2f(kp[d]);
            s += F.rel_bias[t5_bucket(dist) * 16 + hd];
            const float mn = fmaxf(m, s), sc = expf(m - mn), pe = expf(s - mn);
            l = l * sc + pe; m = mn;
#pragma unroll
            for (int d = 0; d < 64; ++d) o[d] = o[d] * sc + pe * bf2f(vp[d]);
        }
        const float inv = 1.0f / l; bf16* op = F.MIX + (size_t)R * DM + hd * 64;
#pragma unroll
        for (int d = 0; d < 64; ++d) op[d] = (bf16)f2bf(o[d] * inv);
        (void)b;
    }
}
__device__ __forceinline__ void s2c_cloc(Frame& F, int gt, int NT) {
    for (int i = gt; i < NCH * (32768 + 128); i += NT) {
        const int ci = i / (32768 + 128), e = i % (32768 + 128);
        const int h = ci & 3, n = (ci >> 2) % NBLK, b = (ci >> 2) / NBLK;
        const bool isn = e >= 32768; const int dqk = e & 127, v = isn ? 0 : e >> 7; float acc = 0.f;
        for (int l = (n == 0 ? NPADR : 0); l < BLK; ++l) { const int row = row_of(b, n * BLK + l);
            const float kw = F.sm[SM_WL + ci * 128 + l] * bf2f(F.KC[(size_t)row * 512 + h * 128 + dqk]);
            acc += isn ? kw : kw * bf2f(F.PROJ[(size_t)row * NPROJ + C_MV + h * 256 + v]); }
        if (isn) F.sm[SM_NLOC + ci * 128 + dqk] = acc; else F.CLOC[(size_t)ci * 32768 + e] = acc;
    }
}
__device__ __forceinline__ void s3_scan(Frame& F, int gt, int NT) {
    for (int i = gt; i < 8 * (32768 + 128); i += NT) {
        const int bh = i / (32768 + 128), e = i % (32768 + 128), b = bh >> 2, h = bh & 3;
        float C = 0.f, m = 0.f;
        for (int n = 0; n < NBLK; ++n) { const int ci = (b * NBLK + n) * 4 + h;
            if (e < 32768) F.CPREV[(size_t)ci * 32768 + e] = (bf16)f2bf(C); else F.sm[SM_NPREV + ci * 128 + e - 32768] = C;
            if (e == 0) F.sm[SM_MPREV + ci] = m;
            const float bl = F.sm[SM_BLAST + ci], ml = F.sm[SM_MLOC + ci], mn = fmaxf(bl + m, ml), a = expf(bl + m - mn), c = expf(ml - mn);
            const float Cl = e < 32768 ? F.CLOC[(size_t)ci * 32768 + e] : F.sm[SM_NLOC + ci * 128 + e - 32768];
            C = a * C + c * Cl; m = mn; }
    }
}
__device__ __forceinline__ void s4a_mt(Frame& F, int gt, int NT) {
    for (int ci = gt; ci < NCH; ci += NT) {
        const int n = (ci >> 2) % NBLK; if (n == 0) continue;
        const float mp = F.sm[SM_MPREV + ci]; float run = -3.0e38f;
        for (int t = 0; t < BLK; ++t) { const float bt = F.sm[SM_BCS + ci * 128 + t]; run = fmaxf(run, F.sm[SM_LI + ci * 128 + t] - bt);
            const float inter = bt + mp, mt = fmaxf(inter, bt + run); F.sm[SM_MT + ci * 128 + t] = mt; F.sm[SM_AT + ci * 128 + t] = expf(inter - mt); }
    }
}
__device__ __forceinline__ void s4b_p(Frame& F, int gt, int NT) {
    for (int i = gt; i < NIT * 16384; i += NT) {
        const int it = i >> 14, t = (i >> 7) & 127, s = i & 127, h = it & 3, n = ((it >> 2) & 31) + 1, b = it >> 7, ci = (b * NBLK + n) * 4 + h;
        float pv = 0.f;
        if (s <= t) { const int rt = row_of(b, n * BLK + t), rs = row_of(b, n * BLK + s);
            const bf16* qp = F.QC + (size_t)rt * 512 + h * 128; const bf16* kp = F.KC + (size_t)rs * 512 + h * 128; float d = 0.f;
            for (int k = 0; k < 128; ++k) d += bf2f(qp[k]) * bf2f(kp[k]);
            pv = d * expf(F.sm[SM_BCS + ci * 128 + t] - F.sm[SM_BCS + ci * 128 + s] + F.sm[SM_LI + ci * 128 + s] - F.sm[SM_MT + ci * 128 + t]); }
        F.PBUF[i] = (bf16)f2bf(pv);
    }
}
__device__ __forceinline__ void s4w_out(Frame& F, int gw, int NGW) {
    for (int i = gw; i < NIT * 128; i += NGW) {
        const int it = i >> 7, t = i & 127, h = it & 3, n = ((it >> 2) & 31) + 1, b = it >> 7, ci = (b * NBLK + n) * 4 + h, v0 = F.lane * 4;
        const int rt = row_of(b, n * BLK + t);
        float num[4] = {0.f, 0.f, 0.f, 0.f}, den = 0.f;
        for (int s = 0; s <= t; ++s) { const float p = bf2f(F.PBUF[(size_t)i * 128 + s]); const bf16* vp = F.PROJ + (size_t)row_of(b, n * BLK + s) * NPROJ + C_MV + h * 256 + v0;
            den += p;
#pragma unroll
            for (int e = 0; e < 4; ++e) num[e] += p * bf2f(vp[e]); }
        const float at = F.sm[SM_AT + ci * 128 + t], mt = F.sm[SM_MT + ci * 128 + t];
        float qn = 0.f, qc4[4] = {0.f, 0.f, 0.f, 0.f};
        for (int k = 0; k < 128; ++k) { const float qv = bf2f(F.QC[(size_t)rt * 512 + h * 128 + k]); qn += qv * F.sm[SM_NPREV + ci * 128 + k];
#pragma unroll
            for (int e = 0; e < 4; ++e) qc4[e] += qv * bf2f(F.CPREV[(size_t)ci * 32768 + (v0 + e) * 128 + k]); }
        den += at * qn; den = fmaxf(fabsf(den), expf(-mt));
        float hv[4], ss = 0.f;
#pragma unroll
        for (int e = 0; e < 4; ++e) { hv[e] = (num[e] + at * qc4[e]) / den; ss += hv[e] * hv[e]; }
        const float r = 1.0f / sqrtf(wave_sum(ss) * (1.0f / 256.0f) + EPS);
#pragma unroll
        for (int e = 0; e < 4; ++e) { const float mo = bf2f(F.PROJ[(size_t)rt * NPROJ + C_MO + h * 256 + v0 + e]);
            F.MIX[(size_t)rt * DM + 1024 + h * 256 + v0 + e] = (bf16)f2bf(hv[e] * r * F.mh_norm[h * 256 + v0 + e] / (1.0f + expf(-mo))); }
    }
}
__device__ __forceinline__ void p_final(Frame& F, int gw, int NGW) {
    for (int r = gw; r < MR; r += NGW) {
        GAS f32x4* xr = (GAS f32x4*)(F.out + (size_t)r * DM) + F.lane; const GAS f32x4* gr = (const GAS f32x4*)F.norm_final + F.lane;
        f32x4 v[8]; float s = 0.f;
#pragma unroll
        for (int j = 0; j < 8; ++j) { v[j] = xr[64 * j]; s += (v[j][0] * v[j][0] + v[j][1] * v[j][1]) + (v[j][2] * v[j][2] + v[j][3] * v[j][3]); }
        const float rstd = 1.0f / sqrtf(wave_sum(s) * (1.f / DM) + EPS);
#pragma unroll
        for (int j = 0; j < 8; ++j) xr[64 * j] = v[j] * rstd * gr[64 * j];
    }
}

#ifndef MK_N_LAUNCHES
#define MK_N_LAUNCHES 1
#endif
constexpr int NPH = 12;
struct Args { const float* in[16]; float* out; unsigned char* ws; int ph_lo, ph_hi; };
__global__ void __launch_bounds__(NTHREADS, 2) hymba_fwd(Args args) {
    extern __shared__ __attribute__((aligned(16))) unsigned char lds[];
    Frame F;
    F.lds = (LAS unsigned char*)lds;
    F.MISC = (volatile LAS unsigned*)(F.lds + MISC_OFF);
    F.tid = threadIdx.x; F.lane = F.tid & 63; F.wave = __builtin_amdgcn_readfirstlane(F.tid >> 6);
    F.G = gridDim.x;
    unsigned char* ws = args.ws;
    F.ctl = (gu32*)(ws + WS_CTL);
    F.x = args.in[0]; F.meta = args.in[1]; F.w_in = args.in[2]; F.conv_w = args.in[3]; F.conv_b = args.in[4]; F.b_ig = args.in[5]; F.b_fg = args.in[6]; F.sinks = args.in[7];
    F.rel_bias = args.in[8]; F.mh_norm = args.in[9]; F.w_out = args.in[10]; F.norm_mix = args.in[11]; F.norm_mlp = args.in[12]; F.w_up = args.in[13]; F.w_down = args.in[14]; F.norm_final = args.in[15];
    F.out = args.out; F.sm = (float*)(ws + WS_SM);
    F.Wup = (bf16*)(ws + WS_WUP); F.Wdn = (bf16*)(ws + WS_WDN); F.XB = (bf16*)(ws + WS_XB); F.ACT = (bf16*)(ws + WS_ACT); F.Win = (bf16*)(ws + WS_WIN); F.Wout = (bf16*)(ws + WS_WOUT);
    F.MIX = (bf16*)(ws + WS_MIX); F.PROJ = (bf16*)(ws + WS_PROJ); F.KC = (bf16*)(ws + WS_KC); F.QC = (bf16*)(ws + WS_QC);
    F.CLOC = (float*)((unsigned char*)args.out + DO_CLOC); F.CPREV = (bf16*)((unsigned char*)args.out + DO_CPREV); F.PBUF = (bf16*)((unsigned char*)args.out + DO_PBUF);
    for (int u = F.tid; u < (LDS_BYTES - LDSCTL_OFF) / 4; u += NTHREADS) ((LAS unsigned*)(F.lds + LDSCTL_OFF))[u] = 0u;
    __syncthreads();
    XcdBarrier bar; bar.bar = (unsigned*)(F.ctl + CW_BAR); bar.x = 0; bar.st = nullptr;
    if (MK_N_LAUNCHES == 1) bar = xcd_barrier_post((unsigned*)(F.ctl + CW_BAR), F.MISC + 8);
    const int lo = args.ph_lo, hi = args.ph_hi;
    const int gw = blockIdx.x * NWAVES + F.wave, NGW = F.G * NWAVES, gt = blockIdx.x * NTHREADS + F.tid, NT = F.G * NTHREADS;
#define IN(k) (lo <= (k) && (k) < hi)
#define SEAM(k) do { if (IN(k) && IN((k) + 1)) xcd_barrier(bar); } while (0)

    if (IN(0)) { p0_rows(F, gw, NGW); p0_transposes(F, 0, 4, gw, NGW); }
    SEAM(0);
    if (IN(1)) {
        pg8::Gemm g{F.XB, F.Win, MROWS, NPROJ, DM}; pg8::StaticOrder S; S.init(MROWS, NPROJ, F.G, (int)blockIdx.x);
        pg8::EpiBf16RowScale E{F.PROJ, NPROJ, F.sm + SM_RSTDX};
        pg8::gemm_phase<pg8::EpiBf16RowScale, pg8::StaticOrder, true, true>(F.lds + RING_OFF, g, S, E);
    }
    SEAM(1);
    if (IN(2)) { s2a_conv(F, gt, NT); s2b_gates(F, gt, NT); s2_attn(F, gt, NT); }
    SEAM(2);
    if (IN(3)) { s2c_cloc(F, gt, NT); }
    SEAM(3);
    if (IN(4)) { s3_scan(F, gt, NT); }
    SEAM(4);
    if (IN(5)) { s4a_mt(F, gt, NT); }
    SEAM(5);
    if (IN(6)) { s4b_p(F, gt, NT); }
    SEAM(6);
    if (IN(7)) { s4w_out(F, gw, NGW); }
    SEAM(7);
    if (IN(8)) {
        pg8::Gemm g{F.MIX, F.Wout, MR, DM, DM}; pg8::StaticOrder S; S.init(MR, DM, F.G, (int)blockIdx.x);
        pg8::EpiResid E{F.x, F.out, F.XB, F.sm + SM_SSQ1, DM};
        pg8::gemm_phase<pg8::EpiResid, pg8::StaticOrder, true, true>(F.lds + RING_OFF, g, S, E);
    }
    SEAM(8);
    if (IN(9)) {
        pg8::Gemm g{F.XB, F.Wup, MR, DFF, DM}; pg8::StaticOrder S; S.init(MR, DFF, F.G, (int)blockIdx.x);
        pg8::EpiSqRelu E{F.ACT, DFF, F.sm + SM_SSQ1, 1.0f / DM, EPS};
        pg8::gemm_phase<pg8::EpiSqRelu, pg8::StaticOrder, true, true>(F.lds + RING_OFF, g, S, E);
    }
    SEAM(9);
    if (IN(10)) {
        pg8::Gemm g{F.ACT, F.Wdn, MR, DM, DFF}; pg8::StaticOrder S; S.init(MR, DM, F.G, (int)blockIdx.x);
        pg8::EpiResid E{F.out, F.out, nullptr, nullptr, DM};
        pg8::gemm_phase<pg8::EpiResid, pg8::StaticOrder, true, true>(F.lds + RING_OFF, g, S, E);
    }
    SEAM(10);
    if (IN(11)) { p_final(F, gw, NGW); }
#undef IN
#undef SEAM
}

extern "C" void kernel_launch(void* const* d_in, const int* in_sizes, int n_in, void* d_out, int out_size, void* d_ws, size_t ws_size, hipStream_t stream) {
    static int grid = 0;
    if (grid == 0) {
        if (n_in != 16 || out_size != MR * DM || ws_size < WS_END) { fprintf(stderr, "kernel_launch: unexpected shapes (n_in %d out %d ws %zu)\n", n_in, out_size, ws_size); grid = -1; return; }
        int dev = 0, cus = 0, per_cu = 0;
        if (hipGetDevice(&dev) != hipSuccess || hipDeviceGetAttribute(&cus, hipDeviceAttributeMultiprocessorCount, dev) != hipSuccess) { grid = -1; return; }
        if (hipFuncSetAttribute((const void*)hymba_fwd, hipFuncAttributeMaxDynamicSharedMemorySize, LDS_BYTES) != hipSuccess) { fprintf(stderr, "kernel_launch: hipFuncSetAttribute failed\n"); grid = -1; return; }
        if (hipOccupancyMaxActiveBlocksPerMultiprocessor(&per_cu, (const void*)hymba_fwd, NTHREADS, LDS_BYTES) != hipSuccess || per_cu < 1) { fprintf(stderr, "kernel_launch: occupancy query says %d blocks per CU\n", per_cu); }
        (void)hipGetLastError();
        grid = cus;
    }
    if (grid < 0) return;
    if (hipMemsetAsync((char*)d_ws + WS_CTL, 0, CTL_ZERO_BYTES, stream) != hipSuccess) return;
    Args a{};
    for (int i = 0; i < 16; ++i) a.in[i] = (const float*)d_in[i];
    a.out = (float*)d_out; a.ws = (unsigned char*)d_ws;
    if (MK_N_LAUNCHES == 1) { a.ph_lo = 0; a.ph_hi = NPH; hipLaunchKernelGGL(hymba_fwd, dim3(grid), dim3(NTHREADS), LDS_BYTES, stream, a); }
    else { for (int p = 0; p < NPH; ++p) { a.ph_lo = p; a.ph_hi = p + 1; hipLaunchKernelGGL(hymba_fwd, dim3(grid), dim3(NTHREADS), LDS_BYTES, stream, a); } }
}
```

```cpp
#ifndef MK_N_LAUNCHES
#define MK_N_LAUNCHES 1
#endif
#include <hip/hip_runtime.h>
#include <cstdio>
#include <cstdint>
namespace pg8 {
#define PG8_LAS __attribute__((address_space(3)))
typedef unsigned short bf16_t;
typedef short bf16x8 __attribute__((ext_vector_type(8)));
typedef float f32x4 __attribute__((ext_vector_type(4)));
typedef unsigned u32x4 __attribute__((ext_vector_type(4)));
constexpr int BM = 256, BK = 64, HALF = 128, HTB = HALF * BK * 2  , STAGE_BYTES = 8 * HTB, NXCD = 8, WGM = 8;

__host__ __device__ __forceinline__ int lds_byte(int r, int c) { const int st = (r >> 4) * 2 + (c >> 5), rr = r & 15, cc = c & 31, ob = rr * 64 + cc * 2; return st * 1024 + (ob ^ (((ob >> 9) & 1) << 5)); }
__host__ __device__ __forceinline__ void stage_rc(int b, int& R, int& C) { const int st = b / 1024, sb = b % 1024, swz = sb ^ (((sb >> 9) & 1) << 5); R = (st >> 1) * 16 + swz / 64; C = (st & 1) * 32 + (swz % 64) / 2; }
__host__ __device__ __forceinline__ int perm32(int rho) { const int n = rho >> 4, i = rho & 15; return 8 * (i >> 2) + 4 * n + (i & 3); }

struct Unit { int pm, pn; };
struct Gemm { const bf16_t* A; const bf16_t* Bt; int M, N, K; };

struct StaticOrder {
    int nM, nN, nwg, G, c;
    __host__ __device__ void init(int M, int N, int G_, int c_) { nM = M / BM; nN = N / BM; nwg = nM * nN; G = G_; c = c_; }
    __host__ __device__ bool next(int i, Unit& u) const {
        const long L = (long)i * G + c; if (L >= nwg) return false;
        int wgid = (int)L; { const int q = nwg / NXCD, r = nwg % NXCD, xcd = wgid % NXCD, off = wgid / NXCD; wgid = (xcd < r ? xcd * (q + 1) : r * (q + 1) + (xcd - r) * q) + off; }
        const int nig = WGM * nN, gid = wgid / nig, fm = gid * WGM, gsz = (nM - fm) < WGM ? (nM - fm) : WGM;
        u.pm = fm + ((wgid % nig) % gsz); u.pn = (wgid % nig) / gsz; return true;
    }
    __device__ __forceinline__ void a_ready(const Unit&) const {}
    __device__ __forceinline__ void done(const Unit&) const {}
};

__device__ __forceinline__ unsigned cvt_pk_bf16(float lo, float hi) { unsigned r; asm volatile("v_cvt_pk_bf16_f32 %0, %1, %2" : "=v"(r) : "v"(lo), "v"(hi)); return r; }

struct EpiBf16RowScale {
    static constexpr bool PERM = true, AFTER_DRAIN = false;
    bf16_t* O; int ldc; const float* rowscale;
    __device__ __forceinline__ void operator()(const f32x4 (&acc)[2][2][4][2], const Unit& u, int wr, int wc, int fr, int fq) const {
        const int row0 = u.pm * BM + wr * 64 + fr; const int col0 = u.pn * BM + wc * 32 + 8 * fq;
#pragma unroll
        for (int ai = 0; ai < 2; ++ai)
#pragma unroll
            for (int m = 0; m < 4; ++m) { const int row = row0 + ai * HALF + m * 16; const float sc = rowscale[row]; bf16_t* rowp = O + (size_t)row * ldc + col0;
#pragma unroll
                for (int bj = 0; bj < 2; ++bj) { f32x4 v0 = acc[ai][bj][m][0] * sc, v1 = acc[ai][bj][m][1] * sc;
                    u32x4 w; w.x = cvt_pk_bf16(v0[0], v0[1]); w.y = cvt_pk_bf16(v0[2], v0[3]); w.z = cvt_pk_bf16(v1[0], v1[1]); w.w = cvt_pk_bf16(v1[2], v1[3]);
                    *(u32x4*)(rowp + bj * HALF) = w; } }
    }
};
struct EpiSqRelu {
    static constexpr bool PERM = true, AFTER_DRAIN = false;
    bf16_t* O; int ldc; const float* ssq; float inv_d, eps;
    __device__ __forceinline__ void operator()(const f32x4 (&acc)[2][2][4][2], const Unit& u, int wr, int wc, int fr, int fq) const {
        const int row0 = u.pm * BM + wr * 64 + fr; const int col0 = u.pn * BM + wc * 32 + 8 * fq;
#pragma unroll
        for (int ai = 0; ai < 2; ++ai)
#pragma unroll
            for (int m = 0; m < 4; ++m) { const int row = row0 + ai * HALF + m * 16;
                const f32x4* sp = (const f32x4*)(ssq + (size_t)row * 32); f32x4 s4 = sp[0];
#pragma unroll
                for (int j = 1; j < 8; ++j) s4 = s4 + sp[j];
                const float sc = 1.0f / sqrtf(((s4[0] + s4[1]) + (s4[2] + s4[3])) * inv_d + eps);
                bf16_t* rowp = O + (size_t)row * ldc + col0;
#pragma unroll
                for (int bj = 0; bj < 2; ++bj) { f32x4 v0 = acc[ai][bj][m][0] * sc, v1 = acc[ai][bj][m][1] * sc;
#pragma unroll
                    for (int e = 0; e < 4; ++e) { const float a = fmaxf(v0[e], 0.f), b = fmaxf(v1[e], 0.f); v0[e] = a * a; v1[e] = b * b; }
                    u32x4 w; w.x = cvt_pk_bf16(v0[0], v0[1]); w.y = cvt_pk_bf16(v0[2], v0[3]); w.z = cvt_pk_bf16(v1[0], v1[1]); w.w = cvt_pk_bf16(v1[2], v1[3]);
                    *(u32x4*)(rowp + bj * HALF) = w; } }
    }
};
struct EpiResid {
    static constexpr bool PERM = false, AFTER_DRAIN = false;
    const float* resid; float* out; bf16_t* outb; float* ssq; int ldc;
    __device__ __forceinline__ void operator()(const f32x4 (&acc)[2][2][4][2], const Unit& u, int wr, int wc, int fr, int fq) const {
        const int row0 = u.pm * BM + wr * 64 + fr; const int col0 = u.pn * BM + wc * 32 + 4 * fq;
        typedef unsigned u32x2v __attribute__((ext_vector_type(2)));
#pragma unroll
        for (int ai = 0; ai < 2; ++ai)
#pragma unroll
            for (int m = 0; m < 4; ++m) { const int row = row0 + ai * HALF + m * 16; const size_t off = (size_t)row * ldc + col0; float s = 0.f;
#pragma unroll
                for (int bj = 0; bj < 2; ++bj)
#pragma unroll
                    for (int n = 0; n < 2; ++n) { const size_t o2 = off + bj * HALF + n * 16; const f32x4 r = *(const f32x4*)(resid + o2); const f32x4 o = r + acc[ai][bj][m][n];
                        *(f32x4*)(out + o2) = o; s += (o[0] * o[0] + o[1] * o[1]) + (o[2] * o[2] + o[3] * o[3]);
                        if (outb) { u32x2v w; w.x = cvt_pk_bf16(o[0], o[1]); w.y = cvt_pk_bf16(o[2], o[3]); *(u32x2v*)(outb + o2) = w; } }
                if (ssq) { s += __shfl_xor(s, 16); s += __shfl_xor(s, 32); if (fq == 0) ssq[(size_t)row * 32 + u.pn * 4 + wc] = s; }
                if (m & 1) asm volatile("" ::: "memory"); }
    }
};

template <class Epi, class Sched, bool ALIGN_EPI = false, bool SP2 = false>
__device__ __forceinline__ void gemm_phase(PG8_LAS unsigned char* lds, const Gemm g, const Sched& S, const Epi& E) {
    const int tid = threadIdx.x, wid = __builtin_amdgcn_readfirstlane(tid >> 6), lane = tid & 63, wr = wid >> 2, wc = wid & 3, fr = lane & 15, fq = lane >> 4;
    const int K = g.K, nt = K / BK;
    unsigned voffA[2], voffB[2];
#pragma unroll
    for (int i = 0; i < 2; ++i) { int R, C; stage_rc(tid * 16 + i * 8192, R, C); const int Rb = Epi::PERM ? ((R & ~31) + perm32(R & 31)) : R;
        voffA[i] = (unsigned)(R * K + C) * 2u; voffB[i] = (unsigned)(Rb * K + C) * 2u; }
    const size_t kstep = (size_t)(BK * 2);
    const size_t hstep = (size_t)HALF * K * 2;
    const size_t tstep = 2 * hstep;
    const unsigned ldsw = (unsigned)wid * 1024u;
    const int aoff = lds_byte(wr * 64 + fr, fq * 8), boff = lds_byte(wc * 32 + fr, fq * 8);
#define PG8_SA(b, h) (((b) * 2 + (h)) * HTB)
#define PG8_SB(b, h) ((4 + (b) * 2 + (h)) * HTB)
#define PG8_STAGE(bufoff, gbase, voff) do { _Pragma("unroll") for (int _i = 0; _i < 2; ++_i) \
        __builtin_amdgcn_global_load_lds((const unsigned*)((const char*)(gbase) + (voff)[_i]), (PG8_LAS unsigned*)(lds + (bufoff) + ldsw + _i * 8192), 16, 0, 0); } while (0)
#define PG8_LDA(dst, b, h) do { _Pragma("unroll") for (int m = 0; m < 4; ++m) _Pragma("unroll") for (int k = 0; k < 2; ++k) dst[m][k] = *(const PG8_LAS bf16x8*)(lds + PG8_SA(b, h) + aoff + m * 2048 + k * 1024); } while (0)
#define PG8_LDB(dst, b, h) do { _Pragma("unroll") for (int n = 0; n < 2; ++n) _Pragma("unroll") for (int k = 0; k < 2; ++k) dst[n][k] = *(const PG8_LAS bf16x8*)(lds + PG8_SB(b, h) + boff + n * 2048 + k * 1024); } while (0)
#define PG8_MMA(ai, bj, At, Bt) do { __builtin_amdgcn_s_setprio(1); _Pragma("unroll") for (int m = 0; m < 4; ++m) _Pragma("unroll") for (int n = 0; n < 2; ++n) _Pragma("unroll") for (int k = 0; k < 2; ++k) \
        acc[ai][bj][m][n] = __builtin_amdgcn_mfma_f32_16x16x32_bf16(Bt[n][k], At[m][k], acc[ai][bj][m][n], 0, 0, 0); __builtin_amdgcn_s_setprio(0); } while (0)
#define PG8_WAIT_V(n) asm volatile("s_waitcnt vmcnt(" #n ")" ::: "memory")
#define PG8_WAIT_L(n) asm volatile("s_waitcnt lgkmcnt(" #n ")" ::: "memory")
#define PG8_BAR __builtin_amdgcn_s_barrier()
#define PG8_SCHED __builtin_amdgcn_sched_barrier(0)
    Unit cur, nxt; int ui = 0;
    if (!S.next(0, cur)) return;
    f32x4 acc[2][2][4][2];
#pragma unroll
    for (int a = 0; a < 2; ++a)
#pragma unroll
        for (int b = 0; b < 2; ++b)
#pragma unroll
            for (int m = 0; m < 4; ++m)
#pragma unroll
                for (int n = 0; n < 2; ++n) acc[a][b][m][n] = (f32x4){0.f, 0.f, 0.f, 0.f};
    bf16x8 At[4][2], B0[2][2], B1[2][2];
    const char* cA = (const char*)g.A + (size_t)cur.pm * tstep; const char* cB = (const char*)g.Bt + (size_t)cur.pn * tstep;
    S.a_ready(cur);
    if constexpr (SP2) {
        PG8_STAGE(PG8_SB(0, 0), cB, voffB); PG8_STAGE(PG8_SB(0, 1), cB + hstep, voffB); PG8_STAGE(PG8_SA(0, 0), cA, voffA); PG8_STAGE(PG8_SA(0, 1), cA + hstep, voffA);
        if (wr == 1) PG8_BAR;
        PG8_WAIT_V(2); PG8_BAR;
        PG8_STAGE(PG8_SB(1, 0), cB + kstep, voffB); PG8_STAGE(PG8_SA(1, 0), cA + kstep, voffA); PG8_STAGE(PG8_SB(1, 1), cB + hstep + kstep, voffB);
        PG8_WAIT_V(6); PG8_BAR;
    } else {
        PG8_STAGE(PG8_SB(0, 0), cB, voffB); PG8_STAGE(PG8_SA(0, 0), cA, voffA); PG8_STAGE(PG8_SB(0, 1), cB + hstep, voffB); PG8_STAGE(PG8_SA(0, 1), cA + hstep, voffA);
        if (wr == 1) PG8_BAR;
        PG8_WAIT_V(4); PG8_BAR;
        PG8_STAGE(PG8_SB(1, 0), cB + kstep, voffB); PG8_STAGE(PG8_SA(1, 0), cA + kstep, voffA); PG8_STAGE(PG8_SB(1, 1), cB + hstep + kstep, voffB);
        PG8_WAIT_V(6); PG8_BAR;
    }
    for (;;) {
        const bool has_next = S.next(ui + 1, nxt);
        const char* nA = has_next ? (const char*)g.A + (size_t)nxt.pm * tstep : cA; const char* nB = has_next ? (const char*)g.Bt + (size_t)nxt.pn * tstep : cB;
        for (int t = 0; t < nt; t += 2) {
            const bool last = (t == nt - 2);
            const char* a1 = cA + (size_t)(t + 1) * kstep;
            const char* a2 = last ? nA : cA + (size_t)(t + 2) * kstep; const char* b2 = last ? nB : cB + (size_t)(t + 2) * kstep;
            const char* a3 = a2 + kstep; const char* b3 = b2 + kstep;
            if (last && has_next) S.a_ready(nxt);
            if constexpr (SP2) {
            PG8_LDB(B0, 0, 0); PG8_LDB(B1, 0, 1); PG8_SCHED; PG8_LDA(At, 0, 0); PG8_STAGE(PG8_SA(1, 1), a1 + hstep, voffA);
            PG8_WAIT_V(8); PG8_WAIT_L(0); PG8_BAR; PG8_MMA(0, 0, At, B0); PG8_MMA(0, 1, At, B1); PG8_BAR; PG8_SCHED;
            PG8_LDA(At, 0, 1); PG8_STAGE(PG8_SB(0, 0), b2, voffB); PG8_STAGE(PG8_SB(0, 1), b2 + hstep, voffB); PG8_STAGE(PG8_SA(0, 0), a2, voffA);
            PG8_WAIT_V(8); PG8_WAIT_L(0); PG8_BAR; PG8_MMA(1, 0, At, B0); PG8_MMA(1, 1, At, B1); PG8_BAR; PG8_SCHED;
            PG8_LDB(B0, 1, 0); PG8_LDB(B1, 1, 1); PG8_SCHED; PG8_LDA(At, 1, 0); PG8_STAGE(PG8_SA(0, 1), a2 + hstep, voffA);
            PG8_WAIT_V(8); PG8_WAIT_L(0); PG8_BAR; PG8_MMA(0, 0, At, B0); PG8_MMA(0, 1, At, B1); PG8_BAR; PG8_SCHED;
            PG8_LDA(At, 1, 1); PG8_STAGE(PG8_SB(1, 0), b3, voffB); PG8_STAGE(PG8_SB(1, 1), b3 + hstep, voffB); PG8_STAGE(PG8_SA(1, 0), a3, voffA);
            PG8_WAIT_V(8); PG8_WAIT_L(0); PG8_BAR; PG8_MMA(1, 0, At, B0); PG8_MMA(1, 1, At, B1); PG8_BAR; PG8_SCHED;
            } else {
            PG8_LDB(B0, 0, 0); PG8_SCHED; PG8_LDA(At, 0, 0); PG8_STAGE(PG8_SA(1, 1), a1 + hstep, voffA);
            PG8_WAIT_L(8); PG8_BAR; PG8_WAIT_L(0); PG8_MMA(0, 0, At, B0); PG8_BAR; PG8_SCHED;
            PG8_LDB(B1, 0, 1); PG8_STAGE(PG8_SB(0, 0), b2, voffB);
            PG8_BAR; PG8_WAIT_L(0); PG8_MMA(0, 1, At, B1); PG8_BAR;
            PG8_LDA(At, 0, 1); PG8_STAGE(PG8_SA(0, 0), a2, voffA);
            PG8_BAR; PG8_WAIT_L(0); PG8_MMA(1, 0, At, B0); PG8_BAR; PG8_SCHED;
            PG8_STAGE(PG8_SB(0, 1), b2 + hstep, voffB);
            PG8_WAIT_V(6); PG8_BAR; PG8_MMA(1, 1, At, B1); PG8_BAR;
            PG8_LDB(B0, 1, 0); PG8_SCHED; PG8_LDA(At, 1, 0); PG8_STAGE(PG8_SA(0, 1), a2 + hstep, voffA);
            PG8_WAIT_L(8); PG8_BAR; PG8_WAIT_L(0); PG8_MMA(0, 0, At, B0); PG8_BAR; PG8_SCHED;
            PG8_LDB(B1, 1, 1); PG8_STAGE(PG8_SB(1, 0), b3, voffB);
            PG8_BAR; PG8_WAIT_L(0); PG8_MMA(0, 1, At, B1); PG8_BAR;
            PG8_LDA(At, 1, 1); PG8_STAGE(PG8_SA(1, 0), a3, voffA);
            PG8_BAR; PG8_WAIT_L(0); PG8_MMA(1, 0, At, B0); PG8_BAR; PG8_SCHED;
            PG8_STAGE(PG8_SB(1, 1), b3 + hstep, voffB);
            PG8_WAIT_V(6); PG8_BAR; PG8_MMA(1, 1, At, B1); PG8_BAR;
            }
        }
        if constexpr (ALIGN_EPI) { if (wr == 0) PG8_BAR; }
        if constexpr (!Epi::AFTER_DRAIN) { E(acc, cur, wr, wc, fr, fq); S.done(cur); }
        if (!has_next) break;
#pragma unroll
        for (int a = 0; a < 2; ++a)
#pragma unroll
            for (int b = 0; b < 2; ++b)
#pragma unroll
                for (int m = 0; m < 4; ++m)
#pragma unroll
                    for (int n = 0; n < 2; ++n) acc[a][b][m][n] = (f32x4){0.f, 0.f, 0.f, 0.f};
        cur = nxt; cA = nA; cB = nB; ++ui;
        if constexpr (ALIGN_EPI) { if (wr == 1) PG8_BAR; }
    }
    PG8_WAIT_V(0);
    if constexpr (!ALIGN_EPI) { if (wr == 0) PG8_BAR; }
    PG8_BAR;
    if constexpr (Epi::AFTER_DRAIN) { E.fused(acc, cur, wr, wc, fr, fq, lds, wid, lane); S.done(cur); }
#undef PG8_SA
#undef PG8_SB
#undef PG8_STAGE
#undef PG8_LDA
#undef PG8_LDB
#undef PG8_MMA
#undef PG8_WAIT_V
#undef PG8_WAIT_L
#undef PG8_BAR
#undef PG8_SCHED
}
}
#define GAS __attribute__((address_space(1)))
#define LAS __attribute__((address_space(3)))
typedef unsigned short bf16;
typedef unsigned v4u __attribute__((ext_vector_type(4)));
typedef float f32x4 __attribute__((ext_vector_type(4)));
typedef short bf16x8 __attribute__((ext_vector_type(8)));
typedef GAS unsigned gu32;
typedef GAS unsigned long long gu64;
#define RLX_AGENT __ATOMIC_RELAXED, __HIP_MEMORY_SCOPE_AGENT
#define LDS_WAIT() asm volatile("s_waitcnt lgkmcnt(0)" ::: "memory")
#define VM_WAIT() asm volatile("s_waitcnt vmcnt(0)" ::: "memory")
__device__ __forceinline__ unsigned long long rt() { return __builtin_amdgcn_s_memrealtime(); }
__device__ __forceinline__ unsigned f2bf(float f) { unsigned u = __builtin_bit_cast(unsigned, f); return (u + 0x7fffu + ((u >> 16) & 1u)) >> 16; }
__device__ __forceinline__ unsigned pk2(float lo, float hi) { return f2bf(lo) | (f2bf(hi) << 16); }

#define XB_TMO      128
#define XB_XCNT(j)  (256  + 64 * (j))
#define XB_XSUB(j)  (1280 + 64 * (j))
#define XB_XGEN(j)  (2304 + 64 * (j))
#define XB_TOP      3328
#define XB_TOPGEN   3392
#define XCD_BAR_WORDS 3456
#define XB_SPIN_CAP (1u << 18)

__device__ __forceinline__ unsigned xb_ld(unsigned* p)              { return __hip_atomic_load(p, __ATOMIC_RELAXED, __HIP_MEMORY_SCOPE_AGENT); }
__device__ __forceinline__ unsigned xb_add(unsigned* p, unsigned v) { return __hip_atomic_fetch_add(p, v, __ATOMIC_RELAXED, __HIP_MEMORY_SCOPE_AGENT); }
__device__ __forceinline__ unsigned xb_xcc_id() { return (unsigned)__builtin_amdgcn_s_getreg((3 << 11) | 20) & 0xFu; }
#define XB_SPIN(cond, bar) do { unsigned _sp = 0; while (cond) { __builtin_amdgcn_s_sleep(1); \
    if ((++_sp & 255u) == 0u) { if (xb_ld(&(bar)[XB_TMO])) break; if (_sp > XB_SPIN_CAP) { atomicAdd(&(bar)[XB_TMO], 1u); break; } } } } while (0)

struct XcdBarrier {
    unsigned* bar; unsigned x;
    volatile LAS unsigned* st;
};

__device__ __forceinline__ XcdBarrier xcd_barrier_post(unsigned* bar, volatile LAS unsigned* st) {
    XcdBarrier b; b.bar = bar; b.x = xb_xcc_id(); b.st = st;
    if (threadIdx.x == 0) (void)xb_add(&bar[XB_XCNT(b.x)], 1u);
    return b;
}
__device__ __forceinline__ void xcd_barrier_complete(unsigned* bar, unsigned x, unsigned& nloc, unsigned& nx) {
    const unsigned G = gridDim.x * gridDim.y * gridDim.z;
    unsigned sum, cnt, mine, sp = 0u;
    for (;;) {
        sum = 0u; cnt = 0u; mine = 0u;
#pragma unroll
        for (unsigned j = 0; j < 16; ++j) { const unsigned c = xb_ld(&bar[XB_XCNT(j)]); sum += c; cnt += (c > 0u) ? 1u : 0u; mine = (j == x) ? c : mine; }
        if (sum == G) break;
        __builtin_amdgcn_s_sleep(1);
        if ((++sp & 255u) == 0u) { if (xb_ld(&bar[XB_TMO])) break; if (sp > XB_SPIN_CAP) { atomicAdd(&bar[XB_TMO], 1u); break; } }
    }
    nloc = mine > 0u ? mine : 1u; nx = cnt > 0u ? cnt : 1u;
}

__device__ __forceinline__ void xcd_barrier(const XcdBarrier& b) {
    asm volatile("s_waitcnt vmcnt(0)" ::: "memory");
    __syncthreads();
    if (threadIdx.x == 0) {
        unsigned* bar = b.bar;
        __builtin_amdgcn_s_waitcnt(0);
        unsigned nloc = b.st[0], nx = b.st[1];
        if (nloc == 0u) { xcd_barrier_complete(bar, b.x, nloc, nx); b.st[0] = nloc; b.st[1] = nx; }
        const unsigned old = xb_add(&bar[XB_XSUB(b.x)], 1u);
        const unsigned gen = old / nloc;
        if (old + 1u == (gen + 1u) * nloc) {
            __builtin_amdgcn_fence(__ATOMIC_RELEASE, "agent");
            asm volatile("s_waitcnt vmcnt(0)" ::: "memory");
            const unsigned og = xb_add(&bar[XB_TOP], 1u);
            const unsigned tg = og / nx;
            if (og + 1u == (tg + 1u) * nx) xb_add(&bar[XB_TOPGEN], 1u);
            else XB_SPIN(xb_ld(&bar[XB_TOPGEN]) == tg, bar);
            __builtin_amdgcn_fence(__ATOMIC_ACQUIRE, "agent");
            xb_add(&bar[XB_XGEN(b.x)], 1u);
            asm volatile("s_waitcnt vmcnt(0)" ::: "memory");
        } else {
            XB_SPIN(xb_ld(&bar[XB_XGEN(b.x)]) == gen, bar);
            __builtin_amdgcn_fence(__ATOMIC_ACQUIRE, "agent");
            asm volatile("s_waitcnt vmcnt(0)" ::: "memory");
        }
    }
    __syncthreads();
}
constexpr int NWAVES = 8, NTHREADS = 512;
constexpr int BATCH = 2, SEQ = 4096, DM = 2048, NBLK = 33, BLK = 128, NMETA = 16, NPADR = 112;
constexpr int MR = BATCH * SEQ;
constexpr int META0 = MR;
constexpr int MROWS = 8448;
constexpr int NPROJ = 4608, INCOLS = 4616, DFF = 8192;
constexpr int C_AQ = 0, C_AK = 1024, C_AV = 1280, C_MQ = 1536, C_MK = 2048, C_MV = 2560, C_MO = 3584;
constexpr float EPS = 1e-6f, NEGBIG = -1e30f;
constexpr int NCH = BATCH * NBLK * 4;
constexpr int NIT = BATCH * 32 * 4;

constexpr size_t MiB = 1u << 20;
constexpr size_t WS_CTL = 0, CTL_ZERO_BYTES = 1 * MiB;
constexpr size_t WS_SM = 1 * MiB;
constexpr size_t WS_WUP = 8 * MiB, WS_WDN = 40 * MiB;
constexpr size_t WS_XB = 72 * MiB;
constexpr size_t WS_ACT = 105 * MiB;
constexpr size_t WS_WIN = 105 * MiB, WS_WOUT = 123 * MiB, WS_MIX = 131 * MiB, WS_PROJ = 163 * MiB;
constexpr size_t WS_KC = 238 * MiB, WS_QC = 247 * MiB;
constexpr size_t WS_END = 256 * MiB;
static_assert(WS_PROJ + (size_t)MROWS * NPROJ * 2 <= WS_KC && WS_QC + (size_t)MROWS * 512 * 2 <= WS_END, "ws map");
constexpr size_t DO_CLOC = 0, DO_CPREV = 33 * MiB, DO_PBUF = 50 * MiB;
constexpr int SM_RSTDX = 0, SM_GI = SM_RSTDX + MROWS, SM_GF = SM_GI + MROWS * 4, SM_BCS = SM_GF + MROWS * 4, SM_LI = SM_BCS + NCH * 128, SM_WL = SM_LI + NCH * 128,
              SM_BLAST = SM_WL + NCH * 128, SM_MLOC = SM_BLAST + NCH, SM_MPREV = SM_MLOC + NCH, SM_NLOC = SM_MPREV + NCH, SM_NPREV = SM_NLOC + NCH * 128,
              SM_MT = SM_NPREV + NCH * 128, SM_AT = SM_MT + NCH * 128, SM_SSQ1 = ((SM_AT + NCH * 128 + 63) / 64) * 64, SM_END = SM_SSQ1 + MR * 32;
static_assert((size_t)SM_END * 4 <= 7 * MiB, "small arrays");
constexpr int CW_BAR = 4096;

constexpr int RING_OFF = 0, RING_BYTES = 131072;
constexpr int SCR_BYTES = 139264;
constexpr int LDSCTL_OFF = SCR_BYTES, MISC_OFF = LDSCTL_OFF + 320;
constexpr int LDS_BYTES = 147456;
static_assert(MISC_OFF + 128 <= LDS_BYTES, "LDS map");

__device__ __forceinline__ float bf2f(unsigned short h) { return __uint_as_float((unsigned)h << 16); }
__device__ __forceinline__ float wave_sum(float v) {
#pragma unroll
    for (int o = 1; o < 64; o <<= 1) v += __shfl_xor(v, o);
    return v;
}
__device__ __forceinline__ int t5_bucket(int d) {
    if (d < 16) return d;
    return 16 + (d >= 19) + (d >= 21) + (d >= 24) + (d >= 27) + (d >= 31) + (d >= 35) + (d >= 40) + (d >= 46) + (d >= 52) + (d >= 59) + (d >= 67) + (d >= 77) + (d >= 87) + (d >= 99) + (d >= 113);
}
__device__ __forceinline__ int row_of(int b, int p) { return p >= 128 ? b * SEQ + p - 128 : (p >= NPADR ? META0 + p - NPADR : -1); }

struct Frame {
    LAS unsigned char* lds;
    volatile LAS unsigned* MISC;
    gu32* ctl;
    int tid, lane, wave, G;
    const float *x, *meta, *w_in, *conv_w, *conv_b, *b_ig, *b_fg, *sinks, *rel_bias, *mh_norm, *w_out, *norm_mix, *norm_mlp, *w_up, *w_down, *norm_final;
    float* out; float* sm;
    bf16 *Wup, *Wdn, *XB, *ACT, *Win, *Wout, *MIX, *PROJ, *KC, *QC;
    float* CLOC; bf16* CPREV; bf16* PBUF;
};

__device__ __forceinline__ void p0_transpose_item(const float* W, int ldw, int K, const float* g, bf16* WT, LAS float* scr, int kb, int nb, int lane) {
    const int k0 = 64 * kb, n0 = 64 * nb;
#pragma unroll 4
    for (int i = 0; i < 16; ++i) { const int kk = 4 * i + (lane >> 4), nn = (lane & 15) * 4;
        const f32x4 v = *(const GAS f32x4*)(W + (size_t)(k0 + kk) * ldw + n0 + nn); const float s = g ? g[k0 + kk] : 1.f;
        LAS float* d = scr + kk * 65 + nn; d[0] = v[0] * s; d[1] = v[1] * s; d[2] = v[2] * s; d[3] = v[3] * s; }
    LDS_WAIT(); asm volatile("" ::: "memory");
    const int c = lane >> 3;
#pragma unroll
    for (int j = 0; j < 8; ++j) { const int n = (lane & 7) + 8 * j; const LAS float* s = scr + (8 * c) * 65 + n;
        v4u o; o.x = pk2(s[0 * 65], s[1 * 65]); o.y = pk2(s[2 * 65], s[3 * 65]); o.z = pk2(s[4 * 65], s[5 * 65]); o.w = pk2(s[6 * 65], s[7 * 65]);
        *(GAS v4u*)(WT + (size_t)(n0 + n) * K + k0 + 8 * c) = o; }
    LDS_WAIT(); asm volatile("" ::: "memory");
}
__device__ __forceinline__ void p0_transposes(Frame& F, int lo_mat, int hi_mat, int gw, int NGW) {
    LAS float* scr = (LAS float*)(F.lds + F.wave * 16640);
    constexpr int I_IN = (DM / 64) * (NPROJ / 64), I_OUT = (DM / 64) * (DM / 64), I_UP = (DM / 64) * (DFF / 64), I_DN = (DFF / 64) * (DM / 64);
    const int i0 = lo_mat == 0 ? 0 : I_IN, i1 = hi_mat == 1 ? I_IN : I_IN + I_OUT + I_UP + I_DN;
    for (int it = i0 + gw; it < i1; it += NGW) {
        int r = it;
        if (r < I_IN) { p0_transpose_item(F.w_in, INCOLS, DM, F.norm_mix, F.Win, scr, r / (NPROJ / 64), r % (NPROJ / 64), F.lane); continue; } r -= I_IN;
        if (r < I_OUT) { p0_transpose_item(F.w_out, DM, DM, nullptr, F.Wout, scr, r / (DM / 64), r % (DM / 64), F.lane); continue; } r -= I_OUT;
        if (r < I_UP) { p0_transpose_item(F.w_up, DFF, DM, F.norm_mlp, F.Wup, scr, r / (DFF / 64), r % (DFF / 64), F.lane); continue; } r -= I_UP;
        p0_transpose_item(F.w_down, DM, DFF, nullptr, F.Wdn, scr, r / (DM / 64), r % (DM / 64), F.lane);
    }
}
__device__ __forceinline__ void p0_rows(Frame& F, int gw, int NGW) {
    LAS float* gwt = (LAS float*)F.lds;
    for (int i = F.tid; i < DM * 8; i += NTHREADS) { const int k = i >> 3, j = i & 7; gwt[i] = F.norm_mix[k] * F.w_in[(size_t)k * INCOLS + NPROJ + j]; }
    __syncthreads();
    for (int r = gw; r < MROWS; r += NGW) {
        GAS unsigned long long* o8 = (GAS unsigned long long*)(F.XB + (size_t)r * DM) + F.lane;
        if (r >= META0 + NMETA) {
#pragma unroll
            for (int j = 0; j < 8; ++j) o8[64 * j] = 0ull;
            if (F.lane == 0) F.sm[SM_RSTDX + r] = 0.f;
            continue; }
        const float* xrow = r < MR ? F.x + (size_t)r * DM : F.meta + (size_t)(r - META0) * DM;
        const GAS f32x4* xr = (const GAS f32x4*)xrow + F.lane;
        f32x4 v[8]; float s = 0.f;
#pragma unroll
        for (int j = 0; j < 8; ++j) { v[j] = xr[64 * j]; s += (v[j][0] * v[j][0] + v[j][1] * v[j][1]) + (v[j][2] * v[j][2] + v[j][3] * v[j][3]); }
        const float rstd = 1.0f / sqrtf(wave_sum(s) * (1.f / DM) + EPS);
        float g8[8];
#pragma unroll
        for (int q = 0; q < 8; ++q) g8[q] = 0.f;
#pragma unroll
        for (int j = 0; j < 8; ++j) {
            o8[64 * j] = (unsigned long long)pk2(v[j][0], v[j][1]) | ((unsigned long long)pk2(v[j][2], v[j][3]) << 32);
#pragma unroll
            for (int e = 0; e < 4; ++e) { const int k = 4 * (F.lane + 64 * j) + e; const LAS f32x4* t = (const LAS f32x4*)(gwt + k * 8); const f32x4 t0 = t[0], t1 = t[1]; const float xv = v[j][e];
                g8[0] += xv * t0[0]; g8[1] += xv * t0[1]; g8[2] += xv * t0[2]; g8[3] += xv * t0[3]; g8[4] += xv * t1[0]; g8[5] += xv * t1[1]; g8[6] += xv * t1[2]; g8[7] += xv * t1[3]; } }
#pragma unroll
        for (int q = 0; q < 8; ++q) g8[q] = wave_sum(g8[q]);
        if (F.lane == 0) F.sm[SM_RSTDX + r] = rstd;
        if (F.lane < 8) {
            float pre = 0.f;
#pragma unroll
            for (int q = 0; q < 8; ++q) pre = (F.lane == q) ? g8[q] : pre;
            pre *= rstd;
            const int hh = F.lane & 3;
            if (F.lane < 4) { F.sm[SM_GI + r * 4 + hh] = 15.0f * tanhf((pre + F.b_ig[hh]) * (1.0f / 15.0f)); }
            else { const float fp = 15.0f * tanhf((pre + F.b_fg[hh]) * (1.0f / 15.0f));
                   F.sm[SM_GF + r * 4 + hh] = fminf(fp, 0.f) - log1pf(expf(-fabsf(fp))); }
        }
    }
    __syncthreads();
}

__device__ __forceinline__ void s2a_conv(Frame& F, int gt, int NT) {
    for (int i = gt; i < (MR + NMETA) * 1024; i += NT) {
        const int R = i >> 10, c = i & 1023;
        float y = F.conv_b[c];
#pragma unroll
        for (int j = 0; j < 4; ++j) { const int back = 3 - j; int src;
            if (R < MR) { const int t = R & (SEQ - 1); src = (t - back >= 0) ? R - back : META0 + NMETA + (t - back); }
            else { const int m = R - META0; src = (m - back >= 0) ? R - back : -1; }
            if (src >= 0) y += F.conv_w[j * 1024 + c] * bf2f(F.PROJ[(size_t)src * NPROJ + C_MQ + c]); }
        const float sv = y / (1.0f + expf(-y));
        if (c < 512) F.QC[(size_t)R * 512 + c] = (bf16)f2bf(sv * 0.08838834764831845f); else F.KC[(size_t)R * 512 + c - 512] = (bf16)f2bf(sv);
    }
}
__device__ __forceinline__ void s2b_gates(Frame& F, int gt, int NT) {
    for (int ci = gt; ci < NCH; ci += NT) {
        const int h = ci & 3, n = (ci >> 2) % NBLK, b = (ci >> 2) / NBLK; float cum = 0.f;
        for (int l = 0; l < BLK; ++l) { const int row = row_of(b, n * BLK + l); const float lf = row >= 0 ? F.sm[SM_GF + row * 4 + h] : 0.f, li = row >= 0 ? F.sm[SM_GI + row * 4 + h] : NEGBIG;
            cum += lf; F.sm[SM_BCS + ci * 128 + l] = cum; F.sm[SM_LI + ci * 128 + l] = li; }
        float ml = -3.0e38f;
        for (int l = 0; l < BLK; ++l) ml = fmaxf(ml, cum - F.sm[SM_BCS + ci * 128 + l] + F.sm[SM_LI + ci * 128 + l]);
        for (int l = 0; l < BLK; ++l) F.sm[SM_WL + ci * 128 + l] = expf(cum - F.sm[SM_BCS + ci * 128 + l] + F.sm[SM_LI + ci * 128 + l] - ml);
        F.sm[SM_BLAST + ci] = cum; F.sm[SM_MLOC + ci] = ml;
    }
}
__device__ __forceinline__ void s2_attn(Frame& F, int gt, int NT) {
    for (int i = gt; i < MR * 16; i += NT) {
        const int hd = i >> 13, R = i & (MR - 1), b = R >> 12, t = R & (SEQ - 1), p = t + 128, kvh = hd >> 2;
        float q[64], o[64];
        { const bf16* qp = F.PROJ + (size_t)R * NPROJ + C_AQ + hd * 64;
#pragma unroll
          for (int d = 0; d < 64; ++d) { q[d] = bf2f(qp[d]) * 0.125f; o[d] = 0.f; } }
        float m = F.sinks[hd], l = 1.0f;
        const int nband = (t + 1 < 128) ? t + 1 : 128;
        for (int kk = 0; kk < nband + 16; ++kk) {
            int krow, dist;
            if (kk < nband) { dist = kk; krow = R - kk; } else { const int mi = kk - nband; krow = META0 + mi; dist = p - (NPADR + mi); }
            const bf16* kp = F.PROJ + (size_t)krow * NPROJ + C_AK + kvh * 64; const bf16* vp = F.PROJ + (size_t)krow * NPROJ + C_AV + kvh * 64;
            float s = 0.f;
#pragma unroll
            for (int d = 0; d < 64; ++d) s += q[d] * bf2f(kp[d]);
            s += F.rel_bias[t5_bucket(dist) * 16 + hd];
            const float mn = fmaxf(m, s), sc = expf(m - mn), pe = expf(s - mn);
            l = l * sc + pe; m = mn;
#pragma unroll
            for (int d = 0; d < 64; ++d) o[d] = o[d] * sc + pe * bf2f(vp[d]);
        }
        const float inv = 1.0f / l; bf16* op = F.MIX + (size_t)R * DM + hd * 64;
#pragma unroll
        for (int d = 0; d < 64; ++d) op[d] = (bf16)f2bf(o[d] * inv);
        (void)b;
    }
}
__device__ __forceinline__ void s2c_cloc(Frame& F, int gt, int NT) {
    for (int i = gt; i < NCH * (32768 + 128); i += NT) {
        const int ci = i / (32768 + 128), e = i % (32768 + 128);
        const int h = ci & 3, n = (ci >> 2) % NBLK, b = (ci >> 2) / NBLK;
        const bool isn = e >= 32768; const int dqk = e & 127, v = isn ? 0 : e >> 7; float acc = 0.f;
        for (int l = (n == 0 ? NPADR : 0); l < BLK; ++l) { const int row = row_of(b, n * BLK + l);
            const float kw = F.sm[SM_WL + ci * 128 + l] * bf2f(F.KC[(size_t)row * 512 + h * 128 + dqk]);
            acc += isn ? kw : kw * bf2f(F.PROJ[(size_t)row * NPROJ + C_MV + h * 256 + v]); }
        if (isn) F.sm[SM_NLOC + ci * 128 + dqk] = acc; else F.CLOC[(size_t)ci * 32768 + e] = acc;
    }
}
__device__ __forceinline__ void s3_scan(Frame& F, int gt, int NT) {
    for (int i = gt; i < 8 * (32768 + 128); i += NT) {
        const int bh = i / (32768 + 128), e = i % (32768 + 128), b = bh >> 2, h = bh & 3;
        float C = 0.f, m = 0.f;
        for (int n = 0; n < NBLK; ++n) { const int ci = (b * NBLK + n) * 4 + h;
            if (e < 32768) F.CPREV[(size_t)ci * 32768 + e] = (bf16)f2bf(C); else F.sm[SM_NPREV + ci * 128 + e - 32768] = C;
            if (e == 0) F.sm[SM_MPREV + ci] = m;
            const float bl = F.sm[SM_BLAST + ci], ml = F.sm[SM_MLOC + ci], mn = fmaxf(bl + m, ml), a = expf(bl + m - mn), c = expf(ml - mn);
            const float Cl = e < 32768 ? F.CLOC[(size_t)ci * 32768 + e] : F.sm[SM_NLOC + ci * 128 + e - 32768];
            C = a * C + c * Cl; m = mn; }
    }
}
__device__ __forceinline__ void s4a_mt(Frame& F, int gt, int NT) {
    for (int ci = gt; ci < NCH; ci += NT) {
        const int n = (ci >> 2) % NBLK; if (n == 0) continue;
        const float mp = F.sm[SM_MPREV + ci]; float run = -3.0e38f;
        for (int t = 0; t < BLK; ++t) { const float bt = F.sm[SM_BCS + ci * 128 + t]; run = fmaxf(run, F.sm[SM_LI + ci * 128 + t] - bt);
            const float inter = bt + mp, mt = fmaxf(inter, bt + run); F.sm[SM_MT + ci * 128 + t] = mt; F.sm[SM_AT + ci * 128 + t] = expf(inter - mt); }
    }
}
__device__ __forceinline__ void s4b_p(Frame& F, int gt, int NT) {
    for (int i = gt; i < NIT * 16384; i += NT) {
        const int it = i >> 14, t = (i >> 7) & 127, s = i & 127, h = it & 3, n = ((it >> 2) & 31) + 1, b = it >> 7, ci = (b * NBLK + n) * 4 + h;
        float pv = 0.f;
        if (s <= t) { const int rt = row_of(b, n * BLK + t), rs = row_of(b, n * BLK + s);
            const bf16* qp = F.QC + (size_t)rt * 512 + h * 128; const bf16* kp = F.KC + (size_t)rs * 512 + h * 128; float d = 0.f;
            for (int k = 0; k < 128; ++k) d += bf2f(qp[k]) * bf2f(kp[k]);
            pv = d * expf(F.sm[SM_BCS + ci * 128 + t] - F.sm[SM_BCS + ci * 128 + s] + F.sm[SM_LI + ci * 128 + s] - F.sm[SM_MT + ci * 128 + t]); }
        F.PBUF[i] = (bf16)f2bf(pv);
    }
}
__device__ __forceinline__ void s4w_out(Frame& F, int gw, int NGW) {
    for (int i = gw; i < NIT * 128; i += NGW) {
        const int it = i >> 7, t = i & 127, h = it & 3, n = ((it >> 2) & 31) + 1, b = it >> 7, ci = (b * NBLK + n) * 4 + h, v0 = F.lane * 4;
        const int rt = row_of(b, n * BLK + t);
        float num[4] = {0.f, 0.f, 0.f, 0.f}, den = 0.f;
        for (int s = 0; s <= t; ++s) { const float p = bf2f(F.PBUF[(size_t)i * 128 + s]); const bf16* vp = F.PROJ + (size_t)row_of(b, n * BLK + s) * NPROJ + C_MV + h * 256 + v0;
            den += p;
#pragma unroll
            for (int e = 0; e < 4; ++e) num[e] += p * bf2f(vp[e]); }
        const float at = F.sm[SM_AT + ci * 128 + t], mt = F.sm[SM_MT + ci * 128 + t];
        float qn = 0.f, qc4[4] = {0.f, 0.f, 0.f, 0.f};
        for (int k = 0; k < 128; ++k) { const float qv = bf2f(F.QC[(size_t)rt * 512 + h * 128 + k]); qn += qv * F.sm[SM_NPREV + ci * 128 + k];
#pragma unroll
            for (int e = 0; e < 4; ++e) qc4[e] += qv * bf2f(F.CPREV[(size_t)ci * 32768 + (v0 + e) * 128 + k]); }
        den += at * qn; den = fmaxf(fabsf(den), expf(-mt));
        float hv[4], ss = 0.f;
#pragma unroll
        for (int e = 0; e < 4; ++e) { hv[e] = (num[e] + at * qc4[e]) / den; ss += hv[e] * hv[e]; }
        const float r = 1.0f / sqrtf(wave_sum(ss) * (1.0f / 256.0f) + EPS);
#pragma unroll
        for (int e = 0; e < 4; ++e) { const float mo = bf2f(F.PROJ[(size_t)rt * NPROJ + C_MO + h * 256 + v0 + e]);
            F.MIX[(size_t)rt * DM + 1024 + h * 256 + v0 + e] = (bf16)f2bf(hv[e] * r * F.mh_norm[h * 256 + v0 + e] / (1.0f + expf(-mo))); }
    }
}
__device__ __forceinline__ void p_final(Frame& F, int gw, int NGW) {
    for (int r = gw; r < MR; r += NGW) {
        GAS f32x4* xr = (GAS f32x4*)(F.out + (size_t)r * DM) + F.lane; const GAS f32x4* gr = (const GAS f32x4*)F.norm_final + F.lane;
        f32x4 v[8]; float s = 0.f;
#pragma unroll
        for (int j = 0; j < 8; ++j) { v[j] = xr[64 * j]; s += (v[j][0] * v[j][0] + v[j][1] * v[j][1]) + (v[j][2] * v[j][2] + v[j][3] * v[j][3]); }
        const float rstd = 1.0f / sqrtf(wave_sum(s) * (1.f / DM) + EPS);
#pragma unroll
        for (int j = 0; j < 8; ++j) xr[64 * j] = v[j] * rstd * gr[64 * j];
    }
}

typedef short v4i16 __attribute__((ext_vector_type(4)));
typedef unsigned u32x2 __attribute__((ext_vector_type(2)));
__device__ __forceinline__ bf16x8 tr_pair(LAS unsigned char* p0, LAS unsigned char* p1) {
    const v4i16 a = __builtin_amdgcn_ds_read_tr16_b64_v4i16((LAS v4i16*)p0), b = __builtin_amdgcn_ds_read_tr16_b64_v4i16((LAS v4i16*)p1);
    return (bf16x8){a[0], a[1], a[2], a[3], b[0], b[1], b[2], b[3]};
}
template <int RB> __device__ __forceinline__ int offR(int r, int c16) { return r * RB + ((c16 ^ (RB == 256 ? (r & 15) : ((r >> 1) & 7))) << 4); }
template <int RB> __device__ __forceinline__ int offT(int r, int c32) { return r * RB + ((c32 ^ (RB == 128 ? ((r >> 1) & 3) : (r & 7))) << 5); }
__device__ __forceinline__ unsigned cvtpk(float lo, float hi) { unsigned r; asm volatile("v_cvt_pk_bf16_f32 %0, %1, %2" : "=v"(r) : "v"(lo), "v"(hi)); return r; }
__device__ __forceinline__ bf16x8 pack8(float a0, float a1, float a2, float a3, float b0, float b1, float b2, float b3) {
    v4u w; w.x = cvtpk(a0, a1); w.y = cvtpk(a2, a3); w.z = cvtpk(b0, b1); w.w = cvtpk(b2, b3); return __builtin_bit_cast(bf16x8, w);
}
#define MFMA16(a, b, c) __builtin_amdgcn_mfma_f32_16x16x32_bf16((a), (b), (c), 0, 0, 0)

__device__ __forceinline__ void attn_item(Frame& F, int item) {
    const int kvh = item & 3, n = ((item >> 2) & 31) + 1, b = item >> 7, R0 = b * SEQ + (n - 1) * BLK;
    LAS unsigned char* Kt = F.lds; LAS unsigned char* Vt = F.lds + 272 * 128; LAS float* btab = (LAS float*)(F.lds + 2 * 272 * 128);
    for (int i = F.tid; i < 272 * 8; i += NTHREADS) { const int r = i >> 3, c = i & 7;
        const int grow = r < 128 ? (n >= 2 ? R0 - 128 + r : -1) : (r < 256 ? R0 + r - 128 : META0 + r - 256);
        v4u kv = {0u, 0u, 0u, 0u}, vv = {0u, 0u, 0u, 0u};
        if (grow >= 0) { kv = *(const GAS v4u*)(F.PROJ + (size_t)grow * NPROJ + C_AK + kvh * 64 + c * 8); vv = *(const GAS v4u*)(F.PROJ + (size_t)grow * NPROJ + C_AV + kvh * 64 + c * 8); }
        *(LAS v4u*)(Kt + offR<128>(r, c)) = kv; *(LAS v4u*)(Vt + offT<128>(r, c >> 1) + ((c & 1) << 4)) = vv; }
    { const int g = F.tid >> 7, d = F.tid & 127; btab[F.tid] = F.rel_bias[t5_bucket(d) * 16 + kvh * 4 + g]; }
    __syncthreads();
    const int g4 = F.wave >> 1, hd = kvh * 4 + g4, half = F.wave & 1, fr = F.lane & 15, fq = F.lane >> 4, q4 = fr >> 2, p4 = fr & 3;
    const float sink = F.sinks[hd];
    for (int tt = 0; tt < 4; ++tt) {
        const int r0 = half * 64 + tt * 16, r = r0 + fr, j0 = r0 >> 4;
        bf16x8 qf[2];
#pragma unroll
        for (int ks = 0; ks < 2; ++ks) qf[ks] = *(const GAS bf16x8*)(F.PROJ + (size_t)(R0 + r) * NPROJ + C_AQ + hd * 64 + ks * 32 + fq * 8);
        f32x4 s[10];
#pragma unroll
        for (int jj = 0; jj < 10; ++jj) { const int rb = (jj < 9 ? 16 * (j0 + jj) : 256) + fr; f32x4 a = {0.f, 0.f, 0.f, 0.f};
#pragma unroll
            for (int ks = 0; ks < 2; ++ks) a = MFMA16(*(LAS bf16x8*)(Kt + offR<128>(rb, ks * 4 + fq)), qf[ks], a);
            s[jj] = a; }
        float mx = sink;
#pragma unroll
        for (int jj = 0; jj < 9; ++jj)
#pragma unroll
            for (int e = 0; e < 4; ++e) { const int c = 16 * (j0 + jj) + 4 * fq + e, dist = r + 128 - c; const bool ok = dist >= 0 && dist < 128 && (n >= 2 || c >= 128);
                const float v = ok ? s[jj][e] * 0.125f + btab[g4 * 128 + (dist & 127)] : NEGBIG; s[jj][e] = v; mx = fmaxf(mx, v); }
#pragma unroll
        for (int e = 0; e < 4; ++e) { const int mi = 4 * fq + e; int dist = (n - 1) * BLK + 16 + r - mi; dist = dist > 127 ? 127 : dist;
            const float v = s[9][e] * 0.125f + btab[g4 * 128 + dist]; s[9][e] = v; mx = fmaxf(mx, v); }
        mx = fmaxf(mx, __shfl_xor(mx, 16)); mx = fmaxf(mx, __shfl_xor(mx, 32));
        float ps = 0.f;
#pragma unroll
        for (int jj = 0; jj < 10; ++jj)
#pragma unroll
            for (int e = 0; e < 4; ++e) { const float pe = __expf(s[jj][e] - mx); s[jj][e] = pe; ps += pe; }
        ps += __shfl_xor(ps, 16); ps += __shfl_xor(ps, 32);
        const float inv = 1.0f / (ps + __expf(sink - mx));
        f32x4 o[4];
#pragma unroll
        for (int dt = 0; dt < 4; ++dt) o[dt] = (f32x4){0.f, 0.f, 0.f, 0.f};
#pragma unroll
        for (int k = 0; k < 5; ++k) { const bf16x8 pf = pack8(s[2 * k][0], s[2 * k][1], s[2 * k][2], s[2 * k][3], s[2 * k + 1][0], s[2 * k + 1][1], s[2 * k + 1][2], s[2 * k + 1][3]);
            const int ra = 16 * (j0 + 2 * k) + 4 * fq + q4, rb = (k < 4 ? 16 * (j0 + 2 * k + 1) : 256) + 4 * fq + q4;
#pragma unroll
            for (int dt = 0; dt < 4; ++dt) { const bf16x8 vf = tr_pair(Vt + offT<128>(ra, dt) + 8 * p4, Vt + offT<128>(rb, dt) + 8 * p4); o[dt] = MFMA16(vf, pf, o[dt]); } }
        bf16* op = F.MIX + (size_t)(R0 + r) * DM + hd * 64 + 4 * fq;
#pragma unroll
        for (int dt = 0; dt < 4; ++dt) { u32x2 w; w.x = cvtpk(o[dt][0] * inv, o[dt][1] * inv); w.y = cvtpk(o[dt][2] * inv, o[dt][3] * inv); *(GAS u32x2*)(op + 16 * dt) = w; }
    }
    __syncthreads();
}
__device__ __forceinline__ void f2_attn(Frame& F) { for (int it = blockIdx.x; it < NIT; it += F.G) attn_item(F, it); }

__device__ __forceinline__ void chunk_gates(Frame& F, LAS float* tab, int b, int n, int h) {
    if (F.tid < 128) { const int row = row_of(b, n * BLK + F.tid); tab[F.tid] = row >= 0 ? F.sm[SM_GF + row * 4 + h] : 0.f; tab[128 + F.tid] = row >= 0 ? F.sm[SM_GI + row * 4 + h] : NEGBIG; }
    __syncthreads();
    if (F.wave == 0) {
        const float f0 = tab[2 * F.lane], f1 = tab[2 * F.lane + 1], i0 = tab[128 + 2 * F.lane], i1 = tab[128 + 2 * F.lane + 1];
        const float s1 = f0 + f1; float x = s1;
#pragma unroll
        for (int o = 1; o < 64; o <<= 1) { const float y = __shfl_up(x, o); if (F.lane >= o) x += y; }
        const float b0 = (x - s1) + f0, b1 = x, bl = __shfl(x, 63);
        const float g0 = bl - b0 + i0, g1 = bl - b1 + i1; float ml = fmaxf(g0, g1);
#pragma unroll
        for (int o = 1; o < 64; o <<= 1) ml = fmaxf(ml, __shfl_xor(ml, o));
        tab[2 * F.lane] = b0; tab[2 * F.lane + 1] = b1; tab[256 + 2 * F.lane] = __expf(g0 - ml); tab[256 + 2 * F.lane + 1] = __expf(g1 - ml);
        if (F.lane == 0) { tab[384] = bl; tab[385] = ml; }
        const float x0 = i0 - b0, x1 = fmaxf(x0, i1 - b1); float xm = x1;
#pragma unroll
        for (int o = 1; o < 64; o <<= 1) { const float y = __shfl_up(xm, o); if (F.lane >= o) xm = fmaxf(xm, y); }
        float prev = __shfl_up(xm, 1); if (F.lane == 0) prev = -3.0e38f;
        tab[640 + 2 * F.lane] = fmaxf(prev, x0); tab[641 + 2 * F.lane] = xm;
    }
    __syncthreads();
}
__device__ __forceinline__ void mla_item(Frame& F, int ci) {
    const int h = ci & 3, n = (ci >> 2) % NBLK, b = (ci >> 2) / NBLK;
    LAS unsigned char* KW = F.lds;
    LAS unsigned char* Vt = F.lds + 32768;
    LAS float* tab = (LAS float*)(F.lds + 32768 + 65536);
    chunk_gates(F, tab, b, n, h);
    if (F.tid < 128) { F.sm[SM_BCS + ci * 128 + F.tid] = tab[F.tid]; F.sm[SM_LI + ci * 128 + F.tid] = tab[128 + F.tid]; }
    if (F.tid == 0) { F.sm[SM_BLAST + ci] = tab[384]; F.sm[SM_MLOC + ci] = tab[385]; }
    for (int i = F.tid; i < (n >= 1 ? 4096 : 2048); i += NTHREADS) {
        const bool isq = i >= 2048; const int l = (i >> 4) & 127, c = i & 15, p = n * BLK + l, ch = (isq ? 0 : 512) + h * 128 + c * 8, rowl = row_of(b, p);
        v4u res = {0u, 0u, 0u, 0u};
        if (rowl >= 0) {
            float y[8];
            { const f32x4 b0 = *(const GAS f32x4*)(F.conv_b + ch), b1 = *(const GAS f32x4*)(F.conv_b + ch + 4);
              y[0] = b0[0]; y[1] = b0[1]; y[2] = b0[2]; y[3] = b0[3]; y[4] = b1[0]; y[5] = b1[1]; y[6] = b1[2]; y[7] = b1[3]; }
#pragma unroll
            for (int j = 0; j < 4; ++j) { const int pp = p - (3 - j); const int src = pp >= 0 ? row_of(b, pp) : -1;
                if (src >= 0) { const v4u xv = *(const GAS v4u*)(F.PROJ + (size_t)src * NPROJ + C_MQ + ch);
                    const f32x4 w0 = *(const GAS f32x4*)(F.conv_w + j * 1024 + ch), w1 = *(const GAS f32x4*)(F.conv_w + j * 1024 + ch + 4);
                    y[0] += w0[0] * __uint_as_float(xv.x << 16); y[1] += w0[1] * __uint_as_float(xv.x & 0xffff0000u); y[2] += w0[2] * __uint_as_float(xv.y << 16); y[3] += w0[3] * __uint_as_float(xv.y & 0xffff0000u);
                    y[4] += w1[0] * __uint_as_float(xv.z << 16); y[5] += w1[1] * __uint_as_float(xv.z & 0xffff0000u); y[6] += w1[2] * __uint_as_float(xv.w << 16); y[7] += w1[3] * __uint_as_float(xv.w & 0xffff0000u); } }
            const float qs = isq ? 0.08838834764831845f : 1.0f;
#pragma unroll
            for (int e = 0; e < 8; ++e) y[e] = y[e] / (1.0f + __expf(-y[e])) * qs;
            v4u o; o.x = cvtpk(y[0], y[1]); o.y = cvtpk(y[2], y[3]); o.z = cvtpk(y[4], y[5]); o.w = cvtpk(y[6], y[7]);
            if (isq) *(GAS v4u*)(F.QC + (size_t)rowl * 512 + h * 128 + c * 8) = o;
            else { *(GAS v4u*)(F.KC + (size_t)rowl * 512 + h * 128 + c * 8) = o; const float w = tab[256 + l];
#pragma unroll
                for (int e = 0; e < 8; ++e) y[e] *= w;
                res.x = cvtpk(y[0], y[1]); res.y = cvtpk(y[2], y[3]); res.z = cvtpk(y[4], y[5]); res.w = cvtpk(y[6], y[7]); }
        }
        if (!isq) *(LAS v4u*)(KW + offT<256>(l, c >> 1) + ((c & 1) << 4)) = res;
    }
    for (int i = F.tid; i < 4096; i += NTHREADS) { const int l = i >> 5, c = i & 31, rowl = row_of(b, n * BLK + l); v4u vv = {0u, 0u, 0u, 0u};
        if (rowl >= 0) vv = *(const GAS v4u*)(F.PROJ + (size_t)rowl * NPROJ + C_MV + h * 256 + c * 8);
        *(LAS v4u*)(Vt + offT<512>(l, c >> 1) + ((c & 1) << 4)) = vv; }
    __syncthreads();
    const int fr = F.lane & 15, fq = F.lane >> 4, q4 = fr >> 2, p4 = fr & 3;
    f32x4 acc[8][2];
#pragma unroll
    for (int mt = 0; mt < 8; ++mt) { acc[mt][0] = (f32x4){0.f, 0.f, 0.f, 0.f}; acc[mt][1] = (f32x4){0.f, 0.f, 0.f, 0.f}; }
#pragma unroll
    for (int ks = 0; ks < 4; ++ks) { const int ra = 32 * ks + 4 * fq + q4, rb = ra + 16;
        bf16x8 bfr[2];
#pragma unroll
        for (int i = 0; i < 2; ++i) bfr[i] = tr_pair(Vt + offT<512>(ra, 2 * F.wave + i) + 8 * p4, Vt + offT<512>(rb, 2 * F.wave + i) + 8 * p4);
#pragma unroll
        for (int mt = 0; mt < 8; ++mt) { const bf16x8 afr = tr_pair(KW + offT<256>(ra, mt) + 8 * p4, KW + offT<256>(rb, mt) + 8 * p4);
            acc[mt][0] = MFMA16(afr, bfr[0], acc[mt][0]); acc[mt][1] = MFMA16(afr, bfr[1], acc[mt][1]); } }
#pragma unroll
    for (int i = 0; i < 2; ++i) { float* cp = F.CLOC + (size_t)ci * 32768 + (size_t)(16 * (2 * F.wave + i) + fr) * 128 + 4 * fq;
#pragma unroll
        for (int mt = 0; mt < 8; ++mt) *(GAS f32x4*)(cp + 16 * mt) = acc[mt][i]; }
    if (F.tid < 128) { float s = 0.f; const int dq = F.tid;
        for (int l = 0; l < 128; ++l) s += bf2f(*(LAS unsigned short*)(KW + offT<256>(l, dq >> 4) + (dq & 15) * 2));
        F.sm[SM_NLOC + ci * 128 + dq] = s; }
    __syncthreads();
}
__device__ __forceinline__ void f2_mla(Frame& F) { for (int ci = F.G - 1 - (int)blockIdx.x; ci < NCH; ci += F.G) mla_item(F, ci); }

__device__ __forceinline__ void f3_scan(Frame& F, int gt, int NT) {
    typedef float f32x2v __attribute__((ext_vector_type(2)));
    for (int i = gt; i < 8 * 16384 + 8 * 64; i += NT) {
        const bool isn = i >= 8 * 16384; const int j = isn ? i - 8 * 16384 : i, bh = isn ? j >> 6 : j >> 14, e2 = isn ? (j & 63) : (j & 16383), b = bh >> 2, h = bh & 3;
        f32x2v C = {0.f, 0.f}; float m = 0.f;
#pragma unroll 1
        for (int n0 = 0; n0 < NBLK; n0 += 11) {
            f32x2v cl[11]; float bl[11], ml[11];
#pragma unroll
            for (int k = 0; k < 11; ++k) { const int ci = (b * NBLK + n0 + k) * 4 + h;
                cl[k] = isn ? *(const GAS f32x2v*)(F.sm + SM_NLOC + ci * 128 + 2 * e2) : *(const GAS f32x2v*)(F.CLOC + (size_t)ci * 32768 + 2 * e2);
                bl[k] = F.sm[SM_BLAST + ci]; ml[k] = F.sm[SM_MLOC + ci]; }
#pragma unroll
            for (int k = 0; k < 11; ++k) { const int ci = (b * NBLK + n0 + k) * 4 + h;
                if (isn) *(GAS f32x2v*)(F.sm + SM_NPREV + ci * 128 + 2 * e2) = C; else *(GAS unsigned*)(F.CPREV + (size_t)ci * 32768 + 2 * e2) = cvtpk(C[0], C[1]);
                if (!isn && e2 == 0) F.sm[SM_MPREV + ci] = m;
                const float mn = fmaxf(bl[k] + m, ml[k]), a = __expf(bl[k] + m - mn), c = __expf(ml[k] - mn);
                C = C * a + cl[k] * c; m = mn; }
        }
    }
}

__device__ __forceinline__ void mlo_item(Frame& F, int it) {
    const int h = it & 3, n = ((it >> 2) & 31) + 1, b = it >> 7, ci = (b * NBLK + n) * 4 + h, R0 = b * SEQ + (n - 1) * BLK;
    LAS unsigned char* X = F.lds;
    LAS unsigned char* Y = F.lds + 65536;
    LAS float* tab = (LAS float*)(F.lds + 131072);
    chunk_gates(F, tab, b, n, h);
    if (F.tid < 128) tab[512 + F.tid] = F.sm[SM_NPREV + ci * 128 + F.tid];
    for (int i = F.tid; i < 2048; i += NTHREADS) { const int s = i >> 4, c = i & 15; *(LAS v4u*)(X + offR<256>(s, c)) = *(const GAS v4u*)(F.KC + (size_t)(R0 + s) * 512 + h * 128 + c * 8); }
    for (int i = F.tid; i < 4096; i += NTHREADS) { const int s = i >> 5, c = i & 31; *(LAS v4u*)(Y + offT<512>(s, c >> 1) + ((c & 1) << 4)) = *(const GAS v4u*)(F.PROJ + (size_t)(R0 + s) * NPROJ + C_MV + h * 256 + c * 8); }
    __syncthreads();
    const int tt = F.wave, fr = F.lane & 15, fq = F.lane >> 4, q4 = fr >> 2, p4 = fr & 3, t = 16 * tt + fr, rowt = R0 + t;
    bf16x8 qf[4];
#pragma unroll
    for (int ks = 0; ks < 4; ++ks) qf[ks] = *(const GAS bf16x8*)(F.QC + (size_t)rowt * 512 + h * 128 + 32 * ks + 8 * fq);
    const float bt = tab[t], inter = bt + F.sm[SM_MPREV + ci], mt = fmaxf(inter, bt + tab[640 + t]), at = __expf(inter - mt);
    f32x4 s[8];
#pragma unroll
    for (int jj = 0; jj < 8; ++jj) { s[jj] = (f32x4){0.f, 0.f, 0.f, 0.f};
        if (jj <= tt) {
#pragma unroll
            for (int ks = 0; ks < 4; ++ks) s[jj] = MFMA16(*(LAS bf16x8*)(X + offR<256>(16 * jj + fr, 4 * ks + fq)), qf[ks], s[jj]);
            const f32x4 bs = *(LAS f32x4*)(tab + 16 * jj + 4 * fq), ls = *(LAS f32x4*)(tab + 128 + 16 * jj + 4 * fq);
#pragma unroll
            for (int e = 0; e < 4; ++e) { const int si = 16 * jj + 4 * fq + e; s[jj][e] = si <= t ? s[jj][e] * __expf(bt - bs[e] + ls[e] - mt) : 0.f; } } }
    float den = 0.f;
#pragma unroll
    for (int jj = 0; jj < 8; ++jj) den += (s[jj][0] + s[jj][1]) + (s[jj][2] + s[jj][3]);
    bf16x8 pf[4];
#pragma unroll
    for (int kk = 0; kk < 4; ++kk) pf[kk] = pack8(s[2 * kk][0], s[2 * kk][1], s[2 * kk][2], s[2 * kk][3], s[2 * kk + 1][0], s[2 * kk + 1][1], s[2 * kk + 1][2], s[2 * kk + 1][3]);
    { float qn = 0.f;
#pragma unroll
      for (int ks = 0; ks < 4; ++ks) { const f32x4 n0 = *(LAS f32x4*)(tab + 512 + 32 * ks + 8 * fq), n1 = *(LAS f32x4*)(tab + 512 + 32 * ks + 8 * fq + 4); const v4u qv = __builtin_bit_cast(v4u, qf[ks]);
          qn += __uint_as_float(qv.x << 16) * n0[0] + __uint_as_float(qv.x & 0xffff0000u) * n0[1] + __uint_as_float(qv.y << 16) * n0[2] + __uint_as_float(qv.y & 0xffff0000u) * n0[3]
              + __uint_as_float(qv.z << 16) * n1[0] + __uint_as_float(qv.z & 0xffff0000u) * n1[1] + __uint_as_float(qv.w << 16) * n1[2] + __uint_as_float(qv.w & 0xffff0000u) * n1[3]; }
      den += at * qn; }
    den += __shfl_xor(den, 16); den += __shfl_xor(den, 32);
    const float inv = 1.0f / fmaxf(fabsf(den), __expf(-mt));
    f32x4 acc[16];
#pragma unroll
    for (int vt = 0; vt < 16; ++vt) acc[vt] = (f32x4){0.f, 0.f, 0.f, 0.f};
#pragma unroll
    for (int kk = 0; kk < 4; ++kk) if (2 * kk <= tt) {
        const int ra = 32 * kk + 4 * fq + q4, rb = ra + 16;
#pragma unroll
        for (int vt = 0; vt < 16; ++vt) acc[vt] = MFMA16(tr_pair(Y + offT<512>(ra, vt) + 8 * p4, Y + offT<512>(rb, vt) + 8 * p4), pf[kk], acc[vt]); }
    __syncthreads();
#pragma unroll
    for (int k = 0; k < 8; ++k) { const int i = F.tid + k * NTHREADS; *(LAS v4u*)(X + offR<256>(i >> 4, i & 15)) = *(const GAS v4u*)(F.CPREV + (size_t)ci * 32768 + (size_t)i * 8); }
    __syncthreads();
    bf16x8 qa[4];
#pragma unroll
    for (int ks = 0; ks < 4; ++ks) { const v4u qv = *(const GAS v4u*)(F.QC + (size_t)rowt * 512 + h * 128 + 32 * ks + 8 * fq);
        qa[ks] = pack8(at * __uint_as_float(qv.x << 16), at * __uint_as_float(qv.x & 0xffff0000u), at * __uint_as_float(qv.y << 16), at * __uint_as_float(qv.y & 0xffff0000u),
                       at * __uint_as_float(qv.z << 16), at * __uint_as_float(qv.z & 0xffff0000u), at * __uint_as_float(qv.w << 16), at * __uint_as_float(qv.w & 0xffff0000u)); }
#pragma unroll
    for (int vt = 0; vt < 16; ++vt)
#pragma unroll
        for (int ks = 0; ks < 4; ++ks) acc[vt] = MFMA16(*(LAS bf16x8*)(X + offR<256>(16 * vt + fr, 4 * ks + fq)), qa[ks], acc[vt]);
    float ss = 0.f;
#pragma unroll
    for (int vt = 0; vt < 16; ++vt) { acc[vt] = acc[vt] * inv; ss += (acc[vt][0] * acc[vt][0] + acc[vt][1] * acc[vt][1]) + (acc[vt][2] * acc[vt][2] + acc[vt][3] * acc[vt][3]); }
    ss += __shfl_xor(ss, 16); ss += __shfl_xor(ss, 32);
    const float rn = 1.0f / sqrtf(ss * (1.0f / 256.0f) + EPS);
    const bf16* mop = F.PROJ + (size_t)rowt * NPROJ + C_MO + h * 256 + 4 * fq; bf16* op = F.MIX + (size_t)rowt * DM + 1024 + h * 256 + 4 * fq; const float* nm = F.mh_norm + h * 256 + 4 * fq;
#pragma unroll
    for (int vt = 0; vt < 16; ++vt) { const u32x2 mo = *(const GAS u32x2*)(mop + 16 * vt); const f32x4 g = *(const GAS f32x4*)(nm + 16 * vt);
        const float m0 = __uint_as_float(mo.x << 16), m1 = __uint_as_float(mo.x & 0xffff0000u), m2 = __uint_as_float(mo.y << 16), m3 = __uint_as_float(mo.y & 0xffff0000u);
        u32x2 w; w.x = cvtpk(acc[vt][0] * rn * g[0] / (1.0f + __expf(-m0)), acc[vt][1] * rn * g[1] / (1.0f + __expf(-m1)));
        w.y = cvtpk(acc[vt][2] * rn * g[2] / (1.0f + __expf(-m2)), acc[vt][3] * rn * g[3] / (1.0f + __expf(-m3)));
        *(GAS u32x2*)(op + 16 * vt) = w; }
    __syncthreads();
}
__device__ __forceinline__ void f4_mlo(Frame& F) { for (int it = blockIdx.x; it < NIT; it += F.G) mlo_item(F, it); }

#ifndef MK_N_LAUNCHES
#define MK_N_LAUNCHES 1
#endif
constexpr int NPH = 9;
struct Args { const float* in[16]; float* out; unsigned char* ws; int ph_lo, ph_hi; };
__global__ void __launch_bounds__(NTHREADS, 2) hymba_fwd(Args args) {
    extern __shared__ __attribute__((aligned(16))) unsigned char lds[];
    Frame F;
    F.lds = (LAS unsigned char*)lds;
    F.MISC = (volatile LAS unsigned*)(F.lds + MISC_OFF);
    F.tid = threadIdx.x; F.lane = F.tid & 63; F.wave = __builtin_amdgcn_readfirstlane(F.tid >> 6);
    F.G = gridDim.x;
    unsigned char* ws = args.ws;
    F.ctl = (gu32*)(ws + WS_CTL);
    F.x = args.in[0]; F.meta = args.in[1]; F.w_in = args.in[2]; F.conv_w = args.in[3]; F.conv_b = args.in[4]; F.b_ig = args.in[5]; F.b_fg = args.in[6]; F.sinks = args.in[7];
    F.rel_bias = args.in[8]; F.mh_norm = args.in[9]; F.w_out = args.in[10]; F.norm_mix = args.in[11]; F.norm_mlp = args.in[12]; F.w_up = args.in[13]; F.w_down = args.in[14]; F.norm_final = args.in[15];
    F.out = args.out; F.sm = (float*)(ws + WS_SM);
    F.Wup = (bf16*)(ws + WS_WUP); F.Wdn = (bf16*)(ws + WS_WDN); F.XB = (bf16*)(ws + WS_XB); F.ACT = (bf16*)(ws + WS_ACT); F.Win = (bf16*)(ws + WS_WIN); F.Wout = (bf16*)(ws + WS_WOUT);
    F.MIX = (bf16*)(ws + WS_MIX); F.PROJ = (bf16*)(ws + WS_PROJ); F.KC = (bf16*)(ws + WS_KC); F.QC = (bf16*)(ws + WS_QC);
    F.CLOC = (float*)((unsigned char*)args.out + DO_CLOC); F.CPREV = (bf16*)((unsigned char*)args.out + DO_CPREV); F.PBUF = (bf16*)((unsigned char*)args.out + DO_PBUF);
    for (int u = F.tid; u < (LDS_BYTES - LDSCTL_OFF) / 4; u += NTHREADS) ((LAS unsigned*)(F.lds + LDSCTL_OFF))[u] = 0u;
    __syncthreads();
    XcdBarrier bar; bar.bar = (unsigned*)(F.ctl + CW_BAR); bar.x = 0; bar.st = nullptr;
    if (MK_N_LAUNCHES == 1) bar = xcd_barrier_post((unsigned*)(F.ctl + CW_BAR), F.MISC + 8);
    const int lo = args.ph_lo, hi = args.ph_hi;
    const int gw = blockIdx.x * NWAVES + F.wave, NGW = F.G * NWAVES, gt = blockIdx.x * NTHREADS + F.tid, NT = F.G * NTHREADS;
#define IN(k) (lo <= (k) && (k) < hi)
#define SEAM(k) do { if (IN(k) && IN((k) + 1)) xcd_barrier(bar); } while (0)

    if (IN(0)) { p0_rows(F, gw, NGW); p0_transposes(F, 0, 4, gw, NGW); }
    SEAM(0);
    if (IN(1)) {
        pg8::Gemm g{F.XB, F.Win, MROWS, NPROJ, DM}; pg8::StaticOrder S; S.init(MROWS, NPROJ, F.G, (int)blockIdx.x);
        pg8::EpiBf16RowScale E{F.PROJ, NPROJ, F.sm + SM_RSTDX};
        pg8::gemm_phase<pg8::EpiBf16RowScale, pg8::StaticOrder, true, true>(F.lds + RING_OFF, g, S, E);
    }
    SEAM(1);
    if (IN(2)) { f2_attn(F); f2_mla(F); }
    SEAM(2);
    if (IN(3)) { f3_scan(F, gt, NT); }
    SEAM(3);
    if (IN(4)) { f4_mlo(F); }
    SEAM(4);
    if (IN(5)) {
        pg8::Gemm g{F.MIX, F.Wout, MR, DM, DM}; pg8::StaticOrder S; S.init(MR, DM, F.G, (int)blockIdx.x);
        pg8::EpiResid E{F.x, F.out, F.XB, F.sm + SM_SSQ1, DM};
        pg8::gemm_phase<pg8::EpiResid, pg8::StaticOrder, true, true>(F.lds + RING_OFF, g, S, E);
    }
    SEAM(5);
    if (IN(6)) {
        pg8::Gemm g{F.XB, F.Wup, MR, DFF, DM}; pg8::StaticOrder S; S.init(MR, DFF, F.G, (int)blockIdx.x);
        pg8::EpiSqRelu E{F.ACT, DFF, F.sm + SM_SSQ1, 1.0f / DM, EPS};
        pg8::gemm_phase<pg8::EpiSqRelu, pg8::StaticOrder, true, true>(F.lds + RING_OFF, g, S, E);
    }
    SEAM(6);
    if (IN(7)) {
        pg8::Gemm g{F.ACT, F.Wdn, MR, DM, DFF}; pg8::StaticOrder S; S.init(MR, DM, F.G, (int)blockIdx.x);
        pg8::EpiResid E{F.out, F.out, nullptr, nullptr, DM};
        pg8::gemm_phase<pg8::EpiResid, pg8::StaticOrder, true, true>(F.lds + RING_OFF, g, S, E);
    }
    SEAM(7);
    if (IN(8)) { p_final(F, gw, NGW); }
#undef IN
#undef SEAM
}

extern "C" void kernel_launch(void* const* d_in, const int* in_sizes, int n_in, void* d_out, int out_size, void* d_ws, size_t ws_size, hipStream_t stream) {
    static int grid = 0;
    if (grid == 0) {
        if (n_in != 16 || out_size != MR * DM || ws_size < WS_END) { fprintf(stderr, "kernel_launch: unexpected shapes (n_in %d out %d ws %zu)\n", n_in, out_size, ws_size); grid = -1; return; }
        int dev = 0, cus = 0, per_cu = 0;
        if (hipGetDevice(&dev) != hipSuccess || hipDeviceGetAttribute(&cus, hipDeviceAttributeMultiprocessorCount, dev) != hipSuccess) { grid = -1; return; }
        if (hipFuncSetAttribute((const void*)hymba_fwd, hipFuncAttributeMaxDynamicSharedMemorySize, LDS_BYTES) != hipSuccess) { fprintf(stderr, "kernel_launch: hipFuncSetAttribute failed\n"); grid = -1; return; }
        if (hipOccupancyMaxActiveBlocksPerMultiprocessor(&per_cu, (const void*)hymba_fwd, NTHREADS, LDS_BYTES) != hipSuccess || per_cu < 1) { fprintf(stderr, "kernel_launch: occupancy query says %d blocks per CU\n", per_cu); }
        (void)hipGetLastError();
        grid = cus;
    }
    if (grid < 0) return;
    if (hipMemsetAsync((char*)d_ws + WS_CTL, 0, CTL_ZERO_BYTES, stream) != hipSuccess) return;
    Args a{};
    for (int i = 0; i < 16; ++i) a.in[i] = (const float*)d_in[i];
    a.out = (float*)d_out; a.ws = (unsigned char*)d_ws;
    if (MK_N_LAUNCHES == 1) { a.ph_lo = 0; a.ph_hi = NPH; hipLaunchKernelGGL(hymba_fwd, dim3(grid), dim3(NTHREADS), LDS_BYTES, stream, a); }
    else { for (int p = 0; p < NPH; ++p) { a.ph_lo = p; a.ph_hi = p + 1; hipLaunchKernelGGL(hymba_fwd, dim3(grid), dim3(NTHREADS), LDS_BYTES, stream, a); } }
}
```
